# Optimizing an MI355X kernel written in HIP

```python
import jax, jax.numpy as jnp
from jax import lax
import numpy as np

D_MODEL = 1024
BATCH = 32
SEQ = 2048
DEPTH = 4

GRID_W = 64
CTX_LEN = 256
HEAD_DIM = 64
GROUP_W = D_MODEL // 4
N_HEADS = GROUP_W // HEAD_DIM
N_KV_HEADS = N_HEADS // 2
GQ = N_HEADS // N_KV_HEADS
KV_W = N_KV_HEADS * HEAD_DIM
IN_W = 5 * GROUP_W + 2 * (GROUP_W + 2 * KV_W)
SHORT_CONV = 3
CONF_CONV = 31
WINDOW = 128
Q_BLOCK = 128
N_EXPERTS = 16
EXPERT_FF = D_MODEL
CAPACITY_FACTOR = 2
ROPE_THETA = 10000.0
EPS = 1e-6

kernel_name = "hybrid_headgroup_ec_moe_diffusion_trunk"


def rms_norm(x, g):
    xf = x.astype(jnp.float32)
    y = xf * lax.rsqrt(jnp.mean(xf * xf, axis=-1, keepdims=True) + EPS)
    return (y * g.astype(jnp.float32)).astype(x.dtype)


def layer_norm(x, g, b):
    xf = x.astype(jnp.float32)
    mu = jnp.mean(xf, axis=-1, keepdims=True)
    var = jnp.mean(jnp.square(xf - mu), axis=-1, keepdims=True)
    y = (xf - mu) * lax.rsqrt(var + EPS)
    return (y * g.astype(jnp.float32) + b.astype(jnp.float32)).astype(x.dtype)


def dwconv(x, w):
    k = w.shape[0]
    return lax.conv_general_dilated(x, w[:, None, :].astype(x.dtype), (1,), [(k // 2, k // 2)],
                                    dimension_numbers=('NWC', 'WIO', 'NWC'),
                                    feature_group_count=x.shape[-1])


def split_proj(p):
    sizes = (GROUP_W,) * 5 + (GROUP_W, KV_W, KV_W) * 2
    return jnp.split(p, np.cumsum(sizes)[:-1].tolist(), axis=-1)


def q_heads(t):
    return t.reshape(*t.shape[:-1], N_KV_HEADS, GQ, HEAD_DIM)


def kv_heads(t):
    return t.reshape(*t.shape[:-1], N_KV_HEADS, HEAD_DIM)


def short_conv_mixer(b, c, h, w):
    return b * dwconv(c * h, w)


def conformer_conv(a, g, w, bias, ln_g, ln_b):
    u = a * jax.nn.sigmoid(g)
    u = dwconv(u, w) + bias
    return jax.nn.silu(layer_norm(u, ln_g, ln_b))


def rope_tables(s):
    rows = s // GRID_W
    row = jnp.repeat(jnp.arange(rows), GRID_W).astype(jnp.float32)
    col = (jnp.arange(rows * GRID_W) % GRID_W).astype(jnp.float32)
    quarter = HEAD_DIM // 4
    inv = ROPE_THETA ** (-jnp.arange(quarter, dtype=jnp.float32) / quarter)
    ar = row[:, None] * inv
    ac = col[:, None] * inv
    ang = jnp.concatenate([ar, ar, ac, ac], axis=-1)
    return jnp.cos(ang), jnp.sin(ang)


def apply_rope(x, cos, sin):
    bshape = (cos.shape[0],) + (1,) * (x.ndim - 3) + (HEAD_DIM,)
    c = cos.reshape(bshape).astype(x.dtype)
    s = sin.reshape(bshape).astype(x.dtype)
    xs = x.reshape(*x.shape[:-1], 2, 2, HEAD_DIM // 4)
    rot = jnp.stack([-xs[..., 1, :], xs[..., 0, :]], axis=-2).reshape(x.shape)
    return x * c + rot * s


def gqa_attend(q, k, v, sink=None):
    s = jnp.einsum('bqkgd,bjkd->bkgqj', q, k).astype(jnp.float32) * (HEAD_DIM ** -0.5)
    if sink is not None:
        sl = jnp.broadcast_to(sink.reshape(N_KV_HEADS, GQ)[None, :, :, None, None].astype(jnp.float32),
                              s.shape[:-1] + (1,))
        s = jnp.concatenate([s, sl], axis=-1)
    p = jax.nn.softmax(s, axis=-1)
    if sink is not None:
        p = p[..., :-1]
    return jnp.einsum('bkgqj,bjkd->bqkgd', p.astype(v.dtype), v)


def window_attention(q, k, v, kc, vc, sink):
    bsz, s = q.shape[:2]
    nb = s // Q_BLOCK
    qb = q.reshape(bsz, nb, Q_BLOCK, N_KV_HEADS, GQ, HEAD_DIM)

    def bands(t):
        tp = jnp.pad(t, ((0, 0), (Q_BLOCK, Q_BLOCK), (0, 0), (0, 0)))
        tp = tp.reshape(bsz, nb + 2, Q_BLOCK, N_KV_HEADS, HEAD_DIM)
        return jnp.concatenate([tp[:, :-2], tp[:, 1:-1], tp[:, 2:]], axis=2)

    kw, vw = bands(k), bands(v)
    scale = HEAD_DIM ** -0.5
    s_loc = jnp.einsum('bnqkgd,bnjkd->bnkgqj', qb, kw).astype(jnp.float32) * scale
    s_ctx = jnp.einsum('bnqkgd,bckd->bnkgqc', qb, kc).astype(jnp.float32) * scale
    blk = jnp.arange(nb)[:, None, None] * Q_BLOCK
    qpos = blk + jnp.arange(Q_BLOCK)[None, :, None]
    kpos = blk - Q_BLOCK + jnp.arange(3 * Q_BLOCK)[None, None, :]
    valid = (kpos >= 0) & (kpos < s) & (jnp.abs(qpos - kpos) <= WINDOW)
    s_loc = jnp.where(valid[None, :, None, None], s_loc, -jnp.inf)
    sl = jnp.broadcast_to(sink.reshape(N_KV_HEADS, GQ)[None, None, :, :, None, None].astype(jnp.float32),
                          s_loc.shape[:-1] + (1,))
    p = jax.nn.softmax(jnp.concatenate([s_loc, s_ctx, sl], axis=-1), axis=-1)
    n_loc = 3 * Q_BLOCK
    p_loc = p[..., :n_loc].astype(v.dtype)
    p_ctx = p[..., n_loc:n_loc + kc.shape[1]].astype(v.dtype)
    o = (jnp.einsum('bnkgqj,bnjkd->bnqkgd', p_loc, vw)
         + jnp.einsum('bnkgqc,bckd->bnqkgd', p_ctx, vc))
    return o.reshape(bsz, s, GROUP_W)


def global_attention(q, k, v, kc, vc):
    bsz, s = q.shape[:2]
    nb = s // Q_BLOCK
    kall = jnp.concatenate([k, kc], axis=1)
    vall = jnp.concatenate([v, vc], axis=1)
    qb = jnp.moveaxis(q.reshape(bsz, nb, Q_BLOCK, N_KV_HEADS, GQ, HEAD_DIM), 1, 0)
    o = lax.map(lambda qblk: gqa_attend(qblk, kall, vall), qb)
    return jnp.moveaxis(o, 0, 1).reshape(bsz, s, GROUP_W)


def expert_choice_ffn(h, router, w_gate, w_up, w_down):
    bsz, t, d = h.shape
    cap = CAPACITY_FACTOR * t // N_EXPERTS
    aff = jax.nn.softmax((h @ router).astype(jnp.float32), axis=-1)
    gates, idx = lax.top_k(jnp.swapaxes(aff, 1, 2), cap)
    xs = jax.vmap(lambda hb, ib: hb[ib])(h, idx)
    a = jnp.einsum('becd,edf->becf', xs, w_gate)
    u = jnp.einsum('becd,edf->becf', xs, w_up)
    y = jnp.einsum('becf,efd->becd', jax.nn.silu(a) * u, w_down)
    y = y * gates[..., None].astype(y.dtype)
    return jax.vmap(lambda ib, yb: jnp.zeros((t, d), yb.dtype).at[ib.reshape(-1)].add(yb.reshape(-1, d)))(idx, y)


def layer(x, xc, mods, cmods, n1, n2, w_in, conv_a, conv_b, conv_b_bias, cln_g, cln_b, sink,
          qn_g, kn_g, w_out, router, w_gate, w_up, w_down, cos, sin, need_ctx):
    sh1, sc1, g1, sh2, sc2, g2 = [m[:, None] for m in jnp.split(mods, 6, axis=-1)]
    csh1, csc1, cg1, csh2, csc2, cg2 = [m[:, None] for m in jnp.split(cmods, 6, axis=-1)]
    bsz, s = x.shape[:2]
    lc = xc.shape[1]

    h = rms_norm(x, n1) * (1 + sc1) + sh1
    hc = rms_norm(xc, n1) * (1 + csc1) + csh1
    a_b, a_c, a_h, b_v, b_g, c_q, c_k, c_v, d_q, d_k, d_v = split_proj(h @ w_in)
    ca_b, ca_c, ca_h, cb_v, cb_g, cc_q, cc_k, cc_v, cd_q, cd_k, cd_v = split_proj(hc @ w_in)

    kc_c, vc_c = kv_heads(cc_k), kv_heads(cc_v)
    kc_d, vc_d = rms_norm(kv_heads(cd_k), kn_g), kv_heads(cd_v)

    ya = short_conv_mixer(a_b, a_c, a_h, conv_a)
    yb = conformer_conv(b_v, b_g, conv_b, conv_b_bias, cln_g, cln_b)
    yc = window_attention(apply_rope(q_heads(c_q), cos, sin), apply_rope(kv_heads(c_k), cos, sin),
                          kv_heads(c_v), kc_c, vc_c, sink)
    yd = global_attention(apply_rope(rms_norm(q_heads(d_q), qn_g), cos, sin),
                          apply_rope(rms_norm(kv_heads(d_k), kn_g), cos, sin),
                          kv_heads(d_v), kc_d, vc_d)
    x_new = x + g1 * (jnp.concatenate([ya, yb, yc, yd], axis=-1) @ w_out)
    h2 = rms_norm(x_new, n2) * (1 + sc2) + sh2
    x_new = x_new + g2 * expert_choice_ffn(h2, router, w_gate, w_up, w_down)

    if need_ctx:
        yca = short_conv_mixer(ca_b, ca_c, ca_h, conv_a)
        ycb = conformer_conv(cb_v, cb_g, conv_b, conv_b_bias, cln_g, cln_b)
        ycc = gqa_attend(q_heads(cc_q), kc_c, vc_c, sink).reshape(bsz, lc, GROUP_W)
        ycd = gqa_attend(rms_norm(q_heads(cd_q), qn_g), kc_d, vc_d).reshape(bsz, lc, GROUP_W)
        xc = xc + cg1 * (jnp.concatenate([yca, ycb, ycc, ycd], axis=-1) @ w_out)
        hc2 = rms_norm(xc, n2) * (1 + csc2) + csh2
        xc = xc + cg2 * expert_choice_ffn(hc2, router, w_gate, w_up, w_down)
    return x_new, xc


def setup_inputs(seed: int = 0) -> dict:
    key = jax.random.key(seed)
    ks = jax.random.split(key, 24)
    f32 = jnp.float32
    nrm = lambda k, shape, scale: jax.random.normal(k, shape, f32) * scale
    d = D_MODEL
    return {
        "x": nrm(ks[0], (BATCH, SEQ, d), 1.0),
        "c": nrm(ks[1], (BATCH, d), 1.0),
        "ctx": nrm(ks[2], (BATCH, CTX_LEN, d), 1.0),
        "c_ctx": nrm(ks[3], (d,), 1.0),
        "ada_w": nrm(ks[4], (DEPTH, d, 6 * d), 0.5 * d ** -0.5),
        "ada_b": nrm(ks[5], (DEPTH, 6 * d), 0.01),
        "norm1_g": 1.0 + nrm(ks[6], (DEPTH, d), 0.01),
        "norm2_g": 1.0 + nrm(ks[7], (DEPTH, d), 0.01),
        "w_in": nrm(ks[8], (DEPTH, d, IN_W), d ** -0.5),
        "conv_a_w": nrm(ks[9], (DEPTH, SHORT_CONV, GROUP_W), SHORT_CONV ** -0.5),
        "conv_b_w": nrm(ks[10], (DEPTH, CONF_CONV, GROUP_W), CONF_CONV ** -0.5),
        "conv_b_b": nrm(ks[11], (DEPTH, GROUP_W), 0.01),
        "conv_ln_g": 1.0 + nrm(ks[12], (DEPTH, GROUP_W), 0.01),
        "conv_ln_b": nrm(ks[13], (DEPTH, GROUP_W), 0.01),
        "sink": nrm(ks[14], (DEPTH, N_HEADS), 1.0),
        "q_norm_g": 1.0 + nrm(ks[15], (DEPTH, HEAD_DIM), 0.01),
        "k_norm_g": 1.0 + nrm(ks[16], (DEPTH, HEAD_DIM), 0.01),
        "w_out": nrm(ks[17], (DEPTH, d, d), d ** -0.5),
        "router_w": nrm(ks[18], (DEPTH, d, N_EXPERTS), d ** -0.5),
        "w_gate": nrm(ks[19], (DEPTH, N_EXPERTS, d, EXPERT_FF), d ** -0.5),
        "w_up": nrm(ks[20], (DEPTH, N_EXPERTS, d, EXPERT_FF), d ** -0.5),
        "w_down": nrm(ks[21], (DEPTH, N_EXPERTS, EXPERT_FF, d), EXPERT_FF ** -0.5),
        "final_g": 1.0 + nrm(ks[22], (d,), 0.01),
    }


def reference(x, c, ctx, c_ctx, ada_w, ada_b, norm1_g, norm2_g, w_in, conv_a_w, conv_b_w, conv_b_b,
              conv_ln_g, conv_ln_b, sink, q_norm_g, k_norm_g, w_out, router_w, w_gate, w_up, w_down,
              final_g):
    cos, sin = rope_tables(x.shape[1])
    sc = jax.nn.silu(c)
    scc = jax.nn.silu(c_ctx)[None]
    xc = ctx
    for i in range(DEPTH):
        mods = sc @ ada_w[i] + ada_b[i]
        cmods = scc @ ada_w[i] + ada_b[i]
        x, xc = layer(x, xc, mods, cmods, norm1_g[i], norm2_g[i], w_in[i], conv_a_w[i], conv_b_w[i],
                      conv_b_b[i], conv_ln_g[i], conv_ln_b[i], sink[i], q_norm_g[i], k_norm_g[i],
                      w_out[i], router_w[i], w_gate[i], w_up[i], w_down[i], cos, sin,
                      i < DEPTH - 1)
    return rms_norm(x, final_g)
```

```cpp
#include <hip/hip_runtime.h>
#include <cstdio>
#include <cstdint>

#ifndef MK_PER_PHASE
#define MK_PER_PHASE 0
#endif

#ifndef PH_MASK
#define PH_MASK 0x7ff
#endif
#define PH_ON(k) (((PH_MASK) >> (k)) & 1)
#ifndef REP_MASK
#define REP_MASK 0
#endif
#define REP(k) ((((REP_MASK) >> (k)) & 1) ? 2 : 1)
#define DI __device__ __forceinline__
#define LAS __attribute__((address_space(3)))
typedef unsigned short bf16_t;
typedef short bf16x8 __attribute__((ext_vector_type(8)));
typedef float f32x2 __attribute__((ext_vector_type(2)));
typedef float f32x4 __attribute__((ext_vector_type(4)));
typedef float f32x8 __attribute__((ext_vector_type(8)));
typedef float f32x16 __attribute__((ext_vector_type(16)));
typedef unsigned u32x2 __attribute__((ext_vector_type(2)));
typedef unsigned u32x4 __attribute__((ext_vector_type(4)));
typedef __bf16 bfv2 __attribute__((ext_vector_type(2)));
typedef __bf16 bfv8 __attribute__((ext_vector_type(8)));

constexpr int D = 1024, NB = 32, SEQ = 2048, NL = 4, CTX = 256, HD = 64, INW = 2304, NE = 16;
constexpr int NLAT = NB * SEQ, NCTX = NB * CTX, NTOK = NLAT + NCTX;
constexpr int KPOS = SEQ + CTX;
constexpr int CAP_L = 256, CAP_C = 32;
constexpr int NXS_L = NB * NE * CAP_L, NXS_C = NB * NE * CAP_C, NXS = NXS_L + NXS_C;
constexpr float EPS = 1e-6f;
constexpr float LOG2E = 1.4426950408889634f;

enum { I_X = 0, I_C, I_CTX, I_CCTX, I_ADAW, I_ADAB, I_N1, I_N2, I_WIN, I_CAW, I_CBW, I_CBB, I_CLNG, I_CLNB, I_SINK, I_QNG, I_KNG, I_WOUT, I_ROUTER, I_WGATE, I_WUP, I_WDOWN, I_FINALG };

constexpr size_t al256(size_t x) { return (x + 255) & ~(size_t)255; }
constexpr size_t WS_CTL   = 0;
constexpr size_t WS_MODS  = 65536;
constexpr size_t WS_ROPE  = al256(WS_MODS + (size_t)NL * 33 * 6144 * 4);
constexpr size_t WS_AFF   = al256(WS_ROPE + 64 * 16 * 2 * 4);
constexpr size_t WS_GATE  = al256(WS_AFF + (size_t)(NB * NE * SEQ + NB * NE * CTX) * 4);
constexpr size_t WS_HS    = al256(WS_GATE + (size_t)NXS * 4);
constexpr size_t WS_IDX   = al256(WS_HS + (size_t)NTOK * 4);
constexpr size_t WS_SEL   = al256(WS_IDX + (size_t)NXS * 4);
constexpr size_t WS_XC    = al256(WS_SEL + (size_t)(NLAT + NCTX) * 16 * 2);
constexpr size_t WS_H     = al256(WS_XC + (size_t)NTOK * D * 2);
constexpr size_t WS_R1    = al256(WS_H + (size_t)NTOK * D * 2);
constexpr size_t WS_R2    = al256(WS_R1 + (size_t)NTOK * INW * 2);
constexpr size_t R2_Y = 0, R2_QC = (size_t)NTOK * D * 2, R2_QD = R2_QC + (size_t)NTOK * 256 * 2, R2_KC = R2_QD + (size_t)NTOK * 256 * 2;
constexpr size_t KV_BYTES = (size_t)NB * 2 * KPOS * HD * 2;
constexpr size_t R2_KD = R2_KC + KV_BYTES, R2_VCT = R2_KD + KV_BYTES, R2_VDT = R2_VCT + KV_BYTES, R2_END = R2_VDT + KV_BYTES;
static_assert(R2_END == (size_t)NXS * D * 2, "G overlays Y|Q|K|V exactly");
constexpr size_t WS_WIN   = al256(WS_R2 + R2_END);
constexpr size_t WS_WOUT  = al256(WS_WIN + (size_t)INW * D * 2);
constexpr size_t WS_WGU   = al256(WS_WOUT + (size_t)D * D * 2);
constexpr size_t WS_WD    = al256(WS_WGU + (size_t)NE * 2 * D * D);
constexpr size_t WS_END   = al256(WS_WD + (size_t)NE * D * D);

constexpr int LDS_BYTES = 147456;
constexpr int MISC_OFF  = LDS_BYTES - 256;
constexpr int NTHREADS = 512;

struct Params { const float* in[23]; float* out; unsigned char* ws; int ph_lo, ph_hi; };

DI unsigned pk_bf16(float lo, float hi) { f32x2 v = {lo, hi}; return __builtin_bit_cast(unsigned, __builtin_convertvector(v, bfv2)); }
DI unsigned pk_fp8x4(float a, float b, float c, float d) {
    a = __builtin_amdgcn_fmed3f(a, -448.f, 448.f); b = __builtin_amdgcn_fmed3f(b, -448.f, 448.f); c = __builtin_amdgcn_fmed3f(c, -448.f, 448.f); d = __builtin_amdgcn_fmed3f(d, -448.f, 448.f);
    int w = 0; w = __builtin_amdgcn_cvt_pk_fp8_f32(a, b, w, false); w = __builtin_amdgcn_cvt_pk_fp8_f32(c, d, w, true); return (unsigned)w; }
DI unsigned pk_i8x4(float a, float b, float c, float d) {
    const int ia = (int)rintf(__builtin_amdgcn_fmed3f(a, -127.f, 127.f)), ib = (int)rintf(__builtin_amdgcn_fmed3f(b, -127.f, 127.f)), ic = (int)rintf(__builtin_amdgcn_fmed3f(c, -127.f, 127.f)), id = (int)rintf(__builtin_amdgcn_fmed3f(d, -127.f, 127.f));
    return (unsigned)(ia & 255) | ((unsigned)(ib & 255) << 8) | ((unsigned)(ic & 255) << 16) | ((unsigned)id << 24); }
DI float bf_lo(unsigned u) { return __uint_as_float(u << 16); }
DI float bf_hi(unsigned u) { return __uint_as_float(u & 0xffff0000u); }
template <int CTRL> DI float dpp_mov(float v) { return __builtin_bit_cast(float, __builtin_amdgcn_update_dpp(__builtin_bit_cast(int, v), __builtin_bit_cast(int, v), CTRL, 0xf, 0xf, false)); }
constexpr int DPP_X1 = 0xB1  , DPP_X2 = 0x4E  , DPP_HMIR = 0x141  , DPP_MIR = 0x140  ;
DI void swap16(float& a, float& b) { asm volatile("s_nop 1\n\tv_permlane16_swap_b32 %0, %1" : "+v"(a), "+v"(b)); }
DI void swap32(float& a, float& b) { asm volatile("s_nop 1\n\tv_permlane32_swap_b32 %0, %1" : "+v"(a), "+v"(b)); }
DI float xor32_sum(float v) { float a = v, b = v; swap32(a, b); return a + b; }
DI float xor32_max(float v) { float a = v, b = v; swap32(a, b); return fmaxf(a, b); }
DI float wave_sum(float v) {
    v += dpp_mov<DPP_X1>(v); v += dpp_mov<DPP_X2>(v); v += dpp_mov<DPP_HMIR>(v); v += dpp_mov<DPP_MIR>(v);
    { float a = v, b = v; swap16(a, b); v = a + b; }
    return xor32_sum(v);
}
DI float wave_max(float v) {
    v = fmaxf(v, dpp_mov<DPP_X1>(v)); v = fmaxf(v, dpp_mov<DPP_X2>(v)); v = fmaxf(v, dpp_mov<DPP_HMIR>(v)); v = fmaxf(v, dpp_mov<DPP_MIR>(v));
    { float a = v, b = v; swap16(a, b); v = fmaxf(a, b); }
    return xor32_max(v);
}
DI float fast_sigmoid(float x) { return __builtin_amdgcn_rcpf(1.0f + __builtin_amdgcn_exp2f(-x * LOG2E)); }

#define XB_TMO      128
#define XB_XCNT(j)  (256  + 64 * (j))
#define XB_XSUB(j)  (1280 + 64 * (j))
#define XB_XGEN(j)  (2304 + 64 * (j))
#define XB_TOP      3328
#define XB_TOPGEN   3392
#define XCD_BAR_WORDS 3456
#define XB_SPIN_CAP (1u << 24)

DI unsigned xb_ld(unsigned* p)              { return __hip_atomic_load(p, __ATOMIC_RELAXED, __HIP_MEMORY_SCOPE_AGENT); }
DI unsigned xb_add(unsigned* p, unsigned v) { return __hip_atomic_fetch_add(p, v, __ATOMIC_RELAXED, __HIP_MEMORY_SCOPE_AGENT); }
DI unsigned xb_xcc_id() { return (unsigned)__builtin_amdgcn_s_getreg((3 << 11) | 20) & 0xFu; }
#define XB_SPIN(cond, bar) do { unsigned _sp = 0; while (cond) { __builtin_amdgcn_s_sleep(1); \
    if ((++_sp & 255u) == 0u) { if (xb_ld(&(bar)[XB_TMO])) break; if (_sp > XB_SPIN_CAP) { atomicAdd(&(bar)[XB_TMO], 1u); break; } } } } while (0)

struct XcdBarrier { unsigned* bar; unsigned x; volatile LAS unsigned* st; };

DI XcdBarrier xcd_barrier_post(unsigned* bar, volatile LAS unsigned* st) {
    XcdBarrier b; b.bar = bar; b.x = xb_xcc_id(); b.st = st;
    if (threadIdx.x == 0) (void)xb_add(&bar[XB_XCNT(b.x)], 1u);
    return b;
}
DI void xcd_barrier_complete(unsigned* bar, unsigned x, unsigned& nloc, unsigned& nx) {
    const unsigned G = gridDim.x * gridDim.y * gridDim.z;
    unsigned sum, cnt, mine, sp = 0u;
    for (;;) {
        sum = 0u; cnt = 0u; mine = 0u;
#pragma unroll
        for (unsigned j = 0; j < 16; ++j) { const unsigned c = xb_ld(&bar[XB_XCNT(j)]); sum += c; cnt += (c > 0u) ? 1u : 0u; mine = (j == x) ? c : mine; }
        if (sum == G) break;
        __builtin_amdgcn_s_sleep(1);
        if ((++sp & 255u) == 0u) { if (xb_ld(&bar[XB_TMO])) break; if (sp > XB_SPIN_CAP) { atomicAdd(&bar[XB_TMO], 1u); break; } }
    }
    nloc = mine > 0u ? mine : 1u; nx = cnt > 0u ? cnt : 1u;
}
DI void xcd_barrier(const XcdBarrier& b) {
    asm volatile("s_waitcnt vmcnt(0)" ::: "memory");
    __syncthreads();
    if (threadIdx.x == 0) {
        unsigned* bar = b.bar;
        __builtin_amdgcn_s_waitcnt(0);
        unsigned nloc = b.st[0], nx = b.st[1];
        if (nloc == 0u) { xcd_barrier_complete(bar, b.x, nloc, nx); b.st[0] = nloc; b.st[1] = nx; }
        const unsigned old = xb_add(&bar[XB_XSUB(b.x)], 1u);
        const unsigned gen = old / nloc;
        if (old + 1u == (gen + 1u) * nloc) {
            __builtin_amdgcn_fence(__ATOMIC_RELEASE, "agent");
            asm volatile("s_waitcnt vmcnt(0)" ::: "memory");
            const unsigned og = xb_add(&bar[XB_TOP], 1u);
            const unsigned tg = og / nx;
            if (og + 1u == (tg + 1u) * nx) xb_add(&bar[XB_TOPGEN], 1u);
            else XB_SPIN(xb_ld(&bar[XB_TOPGEN]) == tg, bar);
            __builtin_amdgcn_fence(__ATOMIC_ACQUIRE, "agent");
            xb_add(&bar[XB_XGEN(b.x)], 1u);
            asm volatile("s_waitcnt vmcnt(0)" ::: "memory");
        } else {
            XB_SPIN(xb_ld(&bar[XB_XGEN(b.x)]) == gen, bar);
            __builtin_amdgcn_fence(__ATOMIC_ACQUIRE, "agent");
            asm volatile("s_waitcnt vmcnt(0)" ::: "memory");
        }
    }
    __syncthreads();
}

namespace pg8 {
constexpr int BM = 256, BK = 64, HALF = 128, HTB = HALF * BK * 2, STAGE_BYTES = 8 * HTB, NXCD = 8, WGM = 8, GK = 1024;
DI int lds_byte(int r, int c) { const int st = (r >> 4) * 2 + (c >> 5), rr = r & 15, cc = c & 31, ob = rr * 64 + cc * 2; return st * 1024 + (ob ^ (((ob >> 9) & 1) << 5)); }
DI void stage_rc(int b, int& R, int& C) { const int st = b / 1024, sb = b % 1024, swz = sb ^ (((sb >> 9) & 1) << 5); R = (st >> 1) * 16 + swz / 64; C = (st & 1) * 32 + (swz % 64) / 2; }
DI int perm32(int rho) { const int n = rho >> 4, i = rho & 15; return 8 * (i >> 2) + 4 * n + (i & 3); }

struct GUnit { const char* a; const char* b; const int* ridx; int pm, pn; };

struct OrderBase {
    int nM, nN, nwg, G, c;
    DI void init(int nM_, int nN_, int G_, int c_) { nM = nM_; nN = nN_; nwg = nM * nN; G = G_; c = c_; }
    DI bool map(int i, int& pm, int& pn) const {
        const long L = (long)i * G + c; if (L >= nwg) return false;
        int wgid = (int)L; { const int q = nwg / NXCD, r = nwg % NXCD, xcd = wgid % NXCD, off = wgid / NXCD; wgid = (xcd < r ? xcd * (q + 1) : r * (q + 1) + (xcd - r) * q) + off; }
        const int nig = WGM * nN, gid = wgid / nig, fm = gid * WGM, gsz = (nM - fm) < WGM ? (nM - fm) : WGM;
        pm = fm + ((wgid % nig) % gsz); pn = (wgid % nig) / gsz; return true;
    }
};
struct RectOrder : OrderBase {
    const char* A; const char* B; size_t tstride;
    DI bool next(int i, GUnit& u) const { int pm, pn; if (!map(i, pm, pn)) return false; u.pm = pm; u.pn = pn; u.a = A + (size_t)pm * tstride; u.ridx = nullptr; u.b = B + (size_t)pn * tstride; return true; }
};
struct MoeOrder : OrderBase {
    const char* A; const char* B; size_t estride; size_t tstride; const int* ridx;
    DI bool next(int i, GUnit& u) const { int pm, pn; if (!map(i, pm, pn)) return false; u.pm = pm; u.pn = pn; const int e = pm < 512 ? (pm >> 5) : ((pm - 512) >> 2);
        u.a = ridx ? A : A + (size_t)pm * tstride; u.ridx = ridx ? ridx + pm * BM : nullptr; u.b = B + (size_t)e * estride + (size_t)pn * tstride; return true; }
};

typedef f32x4 Acc[2][2][4][2];
constexpr int EV_OFF = 8 * 16384, EV_BYTES = 2048;
constexpr float W8_SCALE = 64.0f, W8_INV = 1.0f / 64.0f;

struct EpiBf16Plain {
    static constexpr bool PERM = true;
    bf16_t* O; int ldc;
    DI const char* ev_row(const GUnit&) const { return nullptr; }
    DI const char* ev_col(const GUnit&) const { return nullptr; }
    DI void operator()(const Acc& acc, const GUnit& u, int wr, int wc, int fr, int fq, const LAS float*) const {
        const int row0 = u.pm * BM + wr * 64 + fr, col0 = u.pn * BM + wc * 32 + 8 * fq;
#pragma unroll
        for (int ai = 0; ai < 2; ++ai)
#pragma unroll
            for (int m = 0; m < 4; ++m) { bf16_t* rowp = O + (size_t)(row0 + ai * HALF + m * 16) * ldc + col0;
#pragma unroll
                for (int bj = 0; bj < 2; ++bj) { const f32x4 v0 = acc[ai][bj][m][0], v1 = acc[ai][bj][m][1];
                    u32x4 w; w.x = pk_bf16(v0[0], v0[1]); w.y = pk_bf16(v0[2], v0[3]); w.z = pk_bf16(v1[0], v1[1]); w.w = pk_bf16(v1[2], v1[3]);
                    *(u32x4*)(rowp + bj * HALF) = w; } }
    }
};
constexpr float YD_SCALE = 16.0f, YD_INV = 1.0f / 16.0f;
struct EpiPI8 {
    static constexpr bool PERM = true;
    bf16_t* O; int ldc; const float* rowscale; const unsigned* colmax;
    DI const char* ev_row(const GUnit& u) const { return (const char*)(rowscale + u.pm * BM); }
    DI const char* ev_col(const GUnit& u) const { return (const char*)(colmax + u.pn * BM); }
    DI void operator()(const Acc& acc, const GUnit& u, int wr, int wc, int fr, int fq, const LAS float* ev) const {
        const int rl0 = wr * 64 + fr, cl0 = wc * 32 + 8 * fq;
        const int row0 = u.pm * BM + rl0, col0 = u.pn * BM + cl0;
        f32x4 cs[2][2];
#pragma unroll
        for (int bj = 0; bj < 2; ++bj)
#pragma unroll
            for (int n = 0; n < 2; ++n) cs[bj][n] = *(const LAS f32x4*)(ev + 256 + cl0 + bj * HALF + 4 * n) * (1.0f / 127.0f);
#pragma unroll
        for (int ai = 0; ai < 2; ++ai)
#pragma unroll
            for (int m = 0; m < 4; ++m) { const int row = row0 + ai * HALF + m * 16; const float g = ev[rl0 + ai * HALF + m * 16]; bf16_t* rowp = O + (size_t)row * ldc + col0;
#pragma unroll
                for (int bj = 0; bj < 2; ++bj) { const f32x4 v0 = acc[ai][bj][m][0] * g * cs[bj][0], v1 = acc[ai][bj][m][1] * g * cs[bj][1];
                    u32x4 w; w.x = pk_bf16(v0[0], v0[1]); w.y = pk_bf16(v0[2], v0[3]); w.z = pk_bf16(v1[0], v1[1]); w.w = pk_bf16(v1[2], v1[3]);
                    *(u32x4*)(rowp + bj * HALF) = w; } }
    }
};
struct EpiDown {
    static constexpr bool PERM = true;
    unsigned char* O; const float* gate;
    DI const char* ev_row(const GUnit& u) const { return (const char*)(gate + u.pm * BM); }
    DI const char* ev_col(const GUnit&) const { return nullptr; }
    DI void operator()(const Acc& acc, const GUnit& u, int wr, int wc, int fr, int fq, const LAS float* ev) const {
        const int rl0 = wr * 64 + fr;
        const int row0 = u.pm * BM + rl0, col0 = u.pn * BM + wc * 32 + 8 * fq;
#pragma unroll
        for (int ai = 0; ai < 2; ++ai)
#pragma unroll
            for (int m = 0; m < 4; ++m) { const int row = row0 + ai * HALF + m * 16; const float g = ev[rl0 + ai * HALF + m * 16] * (YD_SCALE / 64.0f); unsigned char* rowp = O + (size_t)row * D + col0;
#pragma unroll
                for (int bj = 0; bj < 2; ++bj) { const f32x4 v0 = acc[ai][bj][m][0] * g, v1 = acc[ai][bj][m][1] * g;
                    u32x2 w; w.x = pk_fp8x4(v0[0], v0[1], v0[2], v0[3]); w.y = pk_fp8x4(v1[0], v1[1], v1[2], v1[3]);
                    *(u32x2*)(rowp + bj * HALF) = w; } }
    }
};
struct EpiGU {
    static constexpr bool PERM = true;
    unsigned char* O;
    DI const char* ev_row(const GUnit&) const { return nullptr; }
    DI const char* ev_col(const GUnit&) const { return nullptr; }
    DI void operator()(const Acc& acc, const GUnit& u, int wr, int wc, int fr, int fq, const LAS float*) const {
        const int row0 = u.pm * BM + wr * 64 + fr, col0 = u.pn * 128 + wc * 32 + 8 * fq;
#pragma unroll
        for (int ai = 0; ai < 2; ++ai)
#pragma unroll
            for (int m = 0; m < 4; ++m) { unsigned char* rowp = O + (size_t)(row0 + ai * HALF + m * 16) * D + col0; float g[8];
#pragma unroll
                for (int n = 0; n < 2; ++n)
#pragma unroll
                    for (int j = 0; j < 4; ++j) { const float aa = acc[ai][0][m][n][j], uu = acc[ai][1][m][n][j];
                        const float e = __builtin_amdgcn_exp2f(aa * (-LOG2E * W8_INV));
                        g[4 * n + j] = (aa * uu) * __builtin_amdgcn_rcpf(__builtin_fmaf(e, W8_SCALE * W8_SCALE, W8_SCALE * W8_SCALE)); }
                u32x2 w; w.x = pk_fp8x4(g[0], g[1], g[2], g[3]); w.y = pk_fp8x4(g[4], g[5], g[6], g[7]);
                *(u32x2*)rowp = w; }
    }
};
struct EpiDelta {
    static constexpr bool PERM = true;
    bf16_t* O; const float* mods_l;
    DI const char* ev_row(const GUnit&) const { return nullptr; }
    DI const char* ev_col(const GUnit& u) const { return (const char*)(mods_l + (size_t)(u.pm >= 256 ? 32 : (u.pm >> 3)) * 6144 + 2048 + u.pn * BM); }
    DI void operator()(const Acc& acc, const GUnit& u, int wr, int wc, int fr, int fq, const LAS float* ev) const {
        const int cl0 = wc * 32 + 8 * fq;
        const int row0 = u.pm * BM + wr * 64 + fr, col0 = u.pn * BM + cl0;
        f32x4 gv[2][2];
#pragma unroll
        for (int bj = 0; bj < 2; ++bj)
#pragma unroll
            for (int n = 0; n < 2; ++n) gv[bj][n] = *(const LAS f32x4*)(ev + 256 + cl0 + bj * HALF + 4 * n);
#pragma unroll
        for (int ai = 0; ai < 2; ++ai)
#pragma unroll
            for (int m = 0; m < 4; ++m) { bf16_t* rowp = O + (size_t)(row0 + ai * HALF + m * 16) * D + col0;
#pragma unroll
                for (int bj = 0; bj < 2; ++bj) { const f32x4 v0 = acc[ai][bj][m][0] * gv[bj][0], v1 = acc[ai][bj][m][1] * gv[bj][1];
                    u32x4 w; w.x = pk_bf16(v0[0], v0[1]); w.y = pk_bf16(v0[2], v0[3]); w.z = pk_bf16(v1[0], v1[1]); w.w = pk_bf16(v1[2], v1[3]);
                    *(u32x4*)(rowp + bj * HALF) = w; } }
    }
};

typedef int i32x8 __attribute__((ext_vector_type(8)));
typedef short s16x16a __attribute__((ext_vector_type(16), aligned(16)));
typedef int i32x4 __attribute__((ext_vector_type(4)));
DI i32x8 frag8(bf16x8 lo, bf16x8 hi) { const i32x4 a = __builtin_bit_cast(i32x4, lo), b = __builtin_bit_cast(i32x4, hi); return (i32x8){a[0], a[1], a[2], a[3], b[0], b[1], b[2], b[3]}; }

DI void mfma_f8_acc(f32x4& acc, const i32x8& a, const i32x8& b) { asm volatile("s_nop 1\n\tv_mfma_f32_16x16x128_f8f6f4 %0, %1, %2, %0" : "+v"(acc) : "v"(a), "v"(b)); }

DI void mfma_zero(f32x4& acc, const u32x2& zz) { asm volatile("s_nop 1\n\tv_mfma_f32_4x4x4_16b_f16 %0, %1, %1, 0" : "=&v"(acc) : "v"(zz)); }
DI void mfma_f8_zero(f32x4& acc, const i32x8& a, const i32x8& b) { asm volatile("s_nop 1\n\tv_mfma_f32_16x16x128_f8f6f4 %0, %1, %2, 0" : "+v"(acc) : "v"(a), "v"(b)); }
DI void mfma_i8_zero(f32x4& acc, const bf16x8& a, const bf16x8& b) { asm volatile("s_nop 1\n\tv_mfma_i32_16x16x64_i8 %0, %1, %2, 0" : "+v"(acc) : "v"(a), "v"(b)); }
DI void mfma_bf16_zero(f32x4& acc, const bf16x8& a, const bf16x8& b) { asm volatile("s_nop 1\n\tv_mfma_f32_16x16x32_bf16 %0, %1, %2, 0" : "+v"(acc) : "v"(a), "v"(b)); }
DI void mfma_i8_acc(f32x4& acc, const bf16x8& a, const bf16x8& b) { asm volatile("s_nop 1\n\tv_mfma_i32_16x16x64_i8 %0, %1, %2, %0" : "+v"(acc) : "v"(a), "v"(b)); }

template <bool GATHER = false, int MODE = 0  , class Epi, class Sched>
DI void gemm_phase(LAS unsigned char* lds, const Sched& S, const Epi& E) {
    int tid = threadIdx.x; asm volatile("" : "+v"(tid));
    const int wid = __builtin_amdgcn_readfirstlane(tid >> 6), lane = tid & 63, wr = wid >> 2, wc = wid & 3, fr = lane & 15, fq = lane >> 4;
    constexpr int ES = MODE == 0 ? 2 : 1  ; constexpr bool F16B = MODE != 1  ;
    constexpr int K = GK, RB = K * ES  , nt = RB / (BK * 2)  ;
    unsigned voffA[2], voffB[2]; int gR[2]; unsigned gC[2];
#pragma unroll
    for (int i = 0; i < 2; ++i) { int R, C; stage_rc(tid * 16 + i * 8192, R, C); const int Rb = Epi::PERM ? ((R & ~31) + perm32(R & 31)) : R;
        voffA[i] = (unsigned)(R * RB + C * 2); voffB[i] = (unsigned)(Rb * RB + C * 2); gR[i] = R; gC[i] = (unsigned)C * 2u; }
    unsigned vgc0[2], vgc1[2], vgn0[2], vgn1[2]; int raw0[2], raw1[2];
    constexpr size_t kstep = (size_t)(BK * 2);
    constexpr size_t hstep = (size_t)HALF * RB;
    const unsigned ldsw = (unsigned)wid * 1024u;
    const int aoff = F16B ? lds_byte(wr * 64 + fr, fq * 8) : lds_byte(wr * 64 + fr, fq * 16), boff = F16B ? lds_byte(wc * 32 + fr, fq * 8) : lds_byte(wc * 32 + fr, fq * 16);
#define PG8_SA(b, h) (((b) * 2 + (h)) * HTB)
#define PG8_SB(b, h) ((4 + (b) * 2 + (h)) * HTB)
#define PG8_STAGE(bufoff, gbase, voff) do { _Pragma("unroll") for (int _i = 0; _i < 2; ++_i) \
        __builtin_amdgcn_global_load_lds((const unsigned*)((const char*)(gbase) + (voff)[_i]), (LAS unsigned*)(lds + (bufoff) + ldsw + _i * 8192), 16, 0, 0); } while (0)
#define PG8_LDA(dst, b, h) do { if (F16B) { _Pragma("unroll") for (int m = 0; m < 4; ++m) _Pragma("unroll") for (int k = 0; k < 2; ++k) dst[m][k] = *(const LAS bf16x8*)(lds + PG8_SA(b, h) + aoff + m * 2048 + k * 1024); } \
        else { _Pragma("unroll") for (int m = 0; m < 4; ++m) dst##8[m] = frag8(*(const LAS bf16x8*)(lds + PG8_SA(b, h) + aoff + m * 2048), *(const LAS bf16x8*)(lds + PG8_SA(b, h) + aoff + m * 2048 + 16)); } } while (0)
#define PG8_LDB(dst, b, h) do { if (F16B) { _Pragma("unroll") for (int n = 0; n < 2; ++n) _Pragma("unroll") for (int k = 0; k < 2; ++k) dst[n][k] = *(const LAS bf16x8*)(lds + PG8_SB(b, h) + boff + n * 2048 + k * 1024); } \
        else { _Pragma("unroll") for (int n = 0; n < 2; ++n) dst##8[n] = frag8(*(const LAS bf16x8*)(lds + PG8_SB(b, h) + boff + n * 2048), *(const LAS bf16x8*)(lds + PG8_SB(b, h) + boff + n * 2048 + 16)); } } while (0)
#define PG8_MMA_(ai, bj, At, Bt, Z) do { __builtin_amdgcn_s_setprio(1); _Pragma("unroll") for (int m = 0; m < 4; ++m) _Pragma("unroll") for (int n = 0; n < 2; ++n) { \
        if (MODE == 0) { _Pragma("unroll") for (int k = 0; k < 2; ++k) { if ((Z) && k == 0) mfma_bf16_zero(acc[ai][bj][m][n], Bt[n][k], At[m][k]); else acc[ai][bj][m][n] = __builtin_amdgcn_mfma_f32_16x16x32_bf16(Bt[n][k], At[m][k], acc[ai][bj][m][n], 0, 0, 0); } } \
        else if (MODE == 2) { _Pragma("unroll") for (int k = 0; k < 2; ++k) { if ((Z) && k == 0) mfma_i8_zero(acc[ai][bj][m][n], Bt[n][k], At[m][k]); else mfma_i8_acc(acc[ai][bj][m][n], Bt[n][k], At[m][k]); } } \
        else { if (Z) mfma_f8_zero(acc[ai][bj][m][n], Bt##8[n], At##8[m]); else mfma_f8_acc(acc[ai][bj][m][n], Bt##8[n], At##8[m]); } } \
        __builtin_amdgcn_s_setprio(0); } while (0)
#define PG8_MMA(ai, bj, At, Bt) PG8_MMA_(ai, bj, At, Bt, false)
#define PG8_MMAZ(ai, bj, At, Bt) PG8_MMA_(ai, bj, At, Bt, true)
#define PG8_WAIT_V(n) asm volatile("s_waitcnt vmcnt(" #n ")" ::: "memory")
#define PG8_WAIT_L(n) asm volatile("s_waitcnt lgkmcnt(" #n ")" ::: "memory")
#define PG8_BAR __builtin_amdgcn_s_barrier()
#define PG8_SCHED __builtin_amdgcn_sched_barrier(0)
    GUnit cur, nxt; int ui = 0;
    if (!S.next(0, cur)) return;
#if GEMM_STAGGER
    for (int d = 0; d < (int)((blockIdx.x >> 3) & 3); ++d) __builtin_amdgcn_s_sleep(GEMM_STAGGER);
#endif
    Acc acc;
#pragma unroll
    for (int a = 0; a < 2; ++a)
#pragma unroll
        for (int b = 0; b < 2; ++b)
#pragma unroll
            for (int m = 0; m < 4; ++m)
#pragma unroll
                for (int n = 0; n < 2; ++n) acc[a][b][m][n] = (f32x4){0.f, 0.f, 0.f, 0.f};
    bf16x8 At[4][2], B0[2][2], B1[2][2];
    i32x8 At8[4], B08[2], B18[2];
    const char* cA = cur.a; const char* cB = cur.b;
    if (GATHER) {
#pragma unroll
        for (int i = 0; i < 2; ++i) { vgc0[i] = (unsigned)cur.ridx[gR[i]] * (unsigned)RB + gC[i]; vgc1[i] = (unsigned)cur.ridx[HALF + gR[i]] * (unsigned)RB + gC[i]; vgn0[i] = vgc0[i]; vgn1[i] = vgc1[i]; raw0[i] = 0; raw1[i] = 0; }
    }
#define PG8_STAGE_A(bufoff, p, h, g0, g1) do { if (GATHER) { if ((h) == 0) PG8_STAGE(bufoff, p, g0); else PG8_STAGE(bufoff, p, g1); } else PG8_STAGE(bufoff, (p) + (h) * hstep, voffA); } while (0)
    PG8_STAGE(PG8_SB(0, 0), cB, voffB); PG8_STAGE(PG8_SB(0, 1), cB + hstep, voffB); PG8_STAGE_A(PG8_SA(0, 0), cA, 0, vgc0, vgc1); PG8_STAGE_A(PG8_SA(0, 1), cA, 1, vgc0, vgc1);
    if (wr == 1) PG8_BAR;
    PG8_WAIT_V(2); PG8_BAR;
    PG8_STAGE(PG8_SB(1, 0), cB + kstep, voffB); PG8_STAGE_A(PG8_SA(1, 0), cA + kstep, 0, vgc0, vgc1); PG8_STAGE(PG8_SB(1, 1), cB + hstep + kstep, voffB);
    PG8_WAIT_V(6); PG8_BAR;
    for (;;) {
        const bool has_next = S.next(ui + 1, nxt);
        const char* nA = has_next ? nxt.a : cA; const char* nB = has_next ? nxt.b : cB;
        if (GATHER && has_next) {
#pragma unroll
            for (int i = 0; i < 2; ++i) { const int* p0 = nxt.ridx + gR[i]; const int* p1 = nxt.ridx + HALF + gR[i];
                asm volatile("global_load_dword %0, %1, off" : "=v"(raw0[i]) : "v"(p0) : "memory"); asm volatile("global_load_dword %0, %1, off" : "=v"(raw1[i]) : "v"(p1) : "memory"); }
        }
#define PG8_TRIP(MMAK0) do { \
            const bool last = (t == nt - 2); \
            if (t == 0) { \
                const char* er = E.ev_row(cur); const char* ec = E.ev_col(cur); \
                if (er != nullptr && wid == 0) __builtin_amdgcn_global_load_lds((const unsigned*)(er + (tid & 63) * 16), (LAS unsigned*)(lds + EV_OFF + (ui & 1) * EV_BYTES), 16, 0, 0); \
                if (ec != nullptr && wid == 1) __builtin_amdgcn_global_load_lds((const unsigned*)(ec + (tid & 63) * 16), (LAS unsigned*)(lds + EV_OFF + (ui & 1) * EV_BYTES + 1024), 16, 0, 0); \
            } \
            const char* a1 = cA + (size_t)(t + 1) * kstep; \
            const char* a2 = last ? nA : cA + (size_t)(t + 2) * kstep; const char* b2 = last ? nB : cB + (size_t)(t + 2) * kstep; \
            const char* a3 = a2 + kstep; const char* b3 = b2 + kstep; \
            if (GATHER && last && has_next) { \
            _Pragma("unroll") \
                for (int i = 0; i < 2; ++i) { asm volatile("" : "+v"(raw0[i])); asm volatile("" : "+v"(raw1[i])); vgn0[i] = (unsigned)raw0[i] * (unsigned)RB + gC[i]; vgn1[i] = (unsigned)raw1[i] * (unsigned)RB + gC[i]; } \
            } \
            unsigned vx0[2], vx1[2]; \
            _Pragma("unroll") \
            for (int i = 0; i < 2; ++i) { vx0[i] = last ? vgn0[i] : vgc0[i]; vx1[i] = last ? vgn1[i] : vgc1[i]; } \
            PG8_LDB(B0, 0, 0); PG8_LDB(B1, 0, 1); PG8_SCHED; PG8_LDA(At, 0, 0); PG8_STAGE_A(PG8_SA(1, 1), a1, 1, vgc0, vgc1); \
            PG8_WAIT_V(8); PG8_WAIT_L(0); PG8_BAR; MMAK0(0, 0, At, B0); MMAK0(0, 1, At, B1); PG8_BAR; PG8_SCHED; \
            PG8_LDA(At, 0, 1); PG8_STAGE(PG8_SB(0, 0), b2, voffB); PG8_STAGE(PG8_SB(0, 1), b2 + hstep, voffB); PG8_STAGE_A(PG8_SA(0, 0), a2, 0, vx0, vx1); \
            PG8_WAIT_V(8); PG8_WAIT_L(0); PG8_BAR; MMAK0(1, 0, At, B0); MMAK0(1, 1, At, B1); PG8_BAR; PG8_SCHED; \
            PG8_LDB(B0, 1, 0); PG8_LDB(B1, 1, 1); PG8_SCHED; PG8_LDA(At, 1, 0); PG8_STAGE_A(PG8_SA(0, 1), a2, 1, vx0, vx1); \
            PG8_WAIT_V(8); PG8_WAIT_L(0); PG8_BAR; PG8_MMA(0, 0, At, B0); PG8_MMA(0, 1, At, B1); PG8_BAR; PG8_SCHED; \
            PG8_LDA(At, 1, 1); PG8_STAGE(PG8_SB(1, 0), b3, voffB); PG8_STAGE(PG8_SB(1, 1), b3 + hstep, voffB); PG8_STAGE_A(PG8_SA(1, 0), a3, 0, vx0, vx1); \
            PG8_WAIT_V(8); PG8_WAIT_L(0); PG8_BAR; PG8_MMA(1, 0, At, B0); PG8_MMA(1, 1, At, B1); PG8_BAR; PG8_SCHED; \
        } while (0)
        { const int t = 0; PG8_TRIP(PG8_MMAZ); }
#pragma unroll 1
        for (int t = 2; t < nt; t += 2) PG8_TRIP(PG8_MMA);
#undef PG8_TRIP
        if (wr == 0) PG8_BAR;
        if (MODE != 0) asm volatile("s_nop 15\n\ts_nop 15" ::: "memory");
        if (MODE == 2) {
#pragma unroll
            for (int a = 0; a < 2; ++a)
#pragma unroll
                for (int b = 0; b < 2; ++b)
#pragma unroll
                    for (int m = 0; m < 4; ++m)
#pragma unroll
                        for (int n = 0; n < 2; ++n)
#pragma unroll
                            for (int j = 0; j < 4; ++j) acc[a][b][m][n][j] = (float)__float_as_int(acc[a][b][m][n][j]);
        }
        E(acc, cur, wr, wc, fr, fq, (const LAS float*)(lds + EV_OFF + (ui & 1) * EV_BYTES));
        if (!has_next) break;
        if (GATHER) {
#pragma unroll
            for (int i = 0; i < 2; ++i) { vgc0[i] = vgn0[i]; vgc1[i] = vgn1[i]; }
        }
        cur = nxt; cA = nA; cB = nB; ++ui;
        if (wr == 1) PG8_BAR;
    }
    PG8_WAIT_V(0);
    PG8_BAR;
#undef PG8_SA
#undef PG8_SB
#undef PG8_STAGE
#undef PG8_STAGE_A
#undef PG8_LDA
#undef PG8_LDB
#undef PG8_MMA
#undef PG8_MMAZ
#undef PG8_MMA_
#undef PG8_WAIT_V
#undef PG8_WAIT_L
#undef PG8_BAR
#undef PG8_SCHED
}
}

struct Frame {
    LAS unsigned char* lds; int tid, lane, wave, G, bid;
    const __attribute__((address_space(4))) Params* P;
#define WSP(T, off) ((T*)(P->ws + (off)))
    DI float* out() const { return P->out; }
    DI float* mods() const { return WSP(float, WS_MODS); }
    DI float* rope() const { return WSP(float, WS_ROPE); }
    DI float* aff() const { return WSP(float, WS_AFF); }
    DI float* gate() const { return WSP(float, WS_GATE); }
    DI short* sel() const { return WSP(short, WS_SEL); }
    DI int* idx() const { return WSP(int, WS_IDX); }
    DI float* hs() const { return WSP(float, WS_HS); }
    DI unsigned* wmax() const { return WSP(unsigned, WS_CTL + 20480); }
    DI bf16_t* xb() const { return WSP(bf16_t, WS_XC); }
    DI bf16_t* H() const { return WSP(bf16_t, WS_H); }
    DI bf16_t* R1() const { return WSP(bf16_t, WS_R1); }
    DI bf16_t* Y() const { return WSP(bf16_t, WS_R2 + R2_Y); }
    DI bf16_t* QC() const { return WSP(bf16_t, WS_R2 + R2_QC); }
    DI bf16_t* QD() const { return WSP(bf16_t, WS_R2 + R2_QD); }
    DI bf16_t* KC() const { return WSP(bf16_t, WS_R2 + R2_KC); }
    DI bf16_t* KD() const { return WSP(bf16_t, WS_R2 + R2_KD); }
    DI bf16_t* VCT() const { return WSP(bf16_t, WS_R2 + R2_VCT); }
    DI bf16_t* VDT() const { return WSP(bf16_t, WS_R2 + R2_VDT); }
    DI bf16_t* Gb() const { return WSP(bf16_t, WS_R2); }
    DI bf16_t* WIN() const { return WSP(bf16_t, WS_WIN); }
    DI bf16_t* WOUT() const { return WSP(bf16_t, WS_WOUT); }
    DI bf16_t* WGU() const { return WSP(bf16_t, WS_WGU); }
    DI bf16_t* WD() const { return WSP(bf16_t, WS_WD); }
};

DI Frame refresh(const Frame& F0) {
    Frame F; int t = threadIdx.x; asm volatile("" : "+v"(t)); F.tid = t; F.lane = t & 63; F.wave = __builtin_amdgcn_readfirstlane(t >> 6);
    const __attribute__((address_space(4))) Params* p = F0.P; asm volatile("" : "+s"(p)); F.P = p; F.lds = F0.lds; F.G = gridDim.x; F.bid = blockIdx.x; return F;
}

__device__ const double ROPE_CS[16][2] = {
  {0.54030230586813977, 0.8414709848078965},
  {0.84600910641876459, 0.53316844604357783},
  {0.95041528091621519, 0.31098359088696603},
  {0.98423023475537852, 0.17689218465882672},
  {0.99500416512926237, 0.099833418129499904},
  {0.99841927779381845, 0.056204499194192764},
  {0.99950004171911222, 0.031617504700607077},
  {0.99984189027985781, 0.017781857090886144},
  {0.99995000041890036, 0.0099998331106604232},
  {0.99998418865337735, 0.0056233836119069999},
  {0.99999500000426333, 0.0031622723591389961},
  {0.99999841886154905, 0.0017782784939288374},
  {0.99999949999999416, 0.00099999988083076933},
  {0.99999984188613433, 0.00056234127206397698},
  {0.99999995000000319, 0.00031622775186866914},
  {0.99999998418861191, 0.00017782793926880789},
};

DI void phase_prologue(const Frame& F0) {
    const Frame F = refresh(F0);
    const int tid = F.tid, w = F.wave, lane = F.lane;
    { LAS f32x4* red = (LAS f32x4*)F.lds;
      for (int u = F.G - 1 - F.bid; u < NL * 36; u += F.G) { const int l = u / 36, cb = u % 36, cq = tid & 15, rg = tid >> 4;
        const f32x4* wp = (const f32x4*)(F.P->in[I_WIN] + (size_t)l * D * INW + cb * 64 + 4 * cq);
        f32x4 mx = (f32x4){0.f, 0.f, 0.f, 0.f};
#pragma unroll
        for (int h = 0; h < 4; ++h) { f32x4 v[8];
#pragma unroll
            for (int r = 0; r < 8; ++r) v[r] = wp[(size_t)(rg + 32 * (8 * h + r)) * (INW / 4)];
#pragma unroll
            for (int r = 0; r < 8; ++r) { mx[0] = fmaxf(mx[0], fabsf(v[r][0])); mx[1] = fmaxf(mx[1], fabsf(v[r][1])); mx[2] = fmaxf(mx[2], fabsf(v[r][2])); mx[3] = fmaxf(mx[3], fabsf(v[r][3])); } }
        __syncthreads();
        red[rg * 16 + cq] = mx;
        __syncthreads();
        if (tid < 64) { const LAS float* rf = (const LAS float*)red; float m = 0.f;
#pragma unroll
            for (int g = 0; g < 32; ++g) m = fmaxf(m, rf[g * 64 + tid]);
            F.wmax()[l * INW + cb * 64 + tid] = __float_as_uint(m); }
      }
    }
    if (F.bid == F.G - 1) {
        for (int i = tid; i < 1024; i += NTHREADS) { const int pos = i >> 4, fi = i & 15; const double c1 = ROPE_CS[fi][0], s1 = ROPE_CS[fi][1]; double c = 1.0, s = 0.0;
            for (int k = 0; k < pos; ++k) { const double cn = c * c1 - s * s1, sn = s * c1 + c * s1; c = cn; s = sn; }
            F.rope()[2 * i] = (float)c; F.rope()[2 * i + 1] = (float)s; }
    }
    LAS float* sv = (LAS float*)F.lds;
    for (int u = F.bid; u < 192; u += F.G) {
        __syncthreads();
        for (int i = tid; i < 33 * 1024; i += NTHREADS) { const int r = i >> 10, k = i & 1023; const float c = (r < 32) ? F.P->in[I_C][r * 1024 + k] : F.P->in[I_CCTX][k]; sv[i] = c / (1.0f + __expf(-c)); }
        __syncthreads();
        const int l = u / 48, cg = u % 48;
        const f32x2* W = (const f32x2*)(F.P->in[I_ADAW] + (size_t)l * 1024 * 6144 + cg * 128 + 2 * lane);
        f32x2 acc[33];
#pragma unroll
        for (int r = 0; r < 33; ++r) acc[r] = (f32x2){0.f, 0.f};
        f32x2 wq[16];
#pragma unroll
        for (int j = 0; j < 16; ++j) wq[j] = W[(size_t)(128 * w + j) * 3072];
        for (int k0 = 128 * w; k0 < 128 * w + 128; k0 += 16) {
            f32x2 wn[16]; const int kn = (k0 + 16 < 128 * w + 128) ? k0 + 16 : k0;
#pragma unroll
            for (int j = 0; j < 16; ++j) wn[j] = W[(size_t)(kn + j) * 3072];
            asm volatile("" ::: "memory");
#pragma unroll
            for (int q = 0; q < 4; ++q) {
#pragma unroll
                for (int r0 = 0; r0 < 33; r0 += 11) {
                    f32x4 s4[11];
#pragma unroll
                    for (int r = 0; r < 11; ++r) s4[r] = *(const LAS f32x4*)(sv + (r0 + r) * 1024 + k0 + 4 * q);
#pragma unroll
                    for (int r = 0; r < 11; ++r) {
                        acc[r0 + r] = __builtin_elementwise_fma((f32x2){s4[r][0], s4[r][0]}, wq[4 * q + 0], acc[r0 + r]); acc[r0 + r] = __builtin_elementwise_fma((f32x2){s4[r][1], s4[r][1]}, wq[4 * q + 1], acc[r0 + r]);
                        acc[r0 + r] = __builtin_elementwise_fma((f32x2){s4[r][2], s4[r][2]}, wq[4 * q + 2], acc[r0 + r]); acc[r0 + r] = __builtin_elementwise_fma((f32x2){s4[r][3], s4[r][3]}, wq[4 * q + 3], acc[r0 + r]); }
                    asm volatile("" ::: "memory"); __builtin_amdgcn_sched_barrier(0);
                }
            }
#pragma unroll
            for (int j = 0; j < 16; ++j) wq[j] = wn[j];
        }
        __syncthreads();
#pragma unroll
        for (int r = 0; r < 33; ++r) *(LAS f32x2*)(sv + (w * 33 + r) * 128 + 2 * lane) = acc[r];
        __syncthreads();
        for (int o = tid; o < 33 * 128; o += NTHREADS) { const int r = o >> 7, c = o & 127; float sum = 0.f;
#pragma unroll
            for (int ww = 0; ww < 8; ++ww) sum += sv[(ww * 33 + r) * 128 + c];
            const int nn = cg * 128 + c; F.mods()[(size_t)(l * 33 + r) * 6144 + nn] = sum + F.P->in[I_ADAB][l * 6144 + nn]; }
    }
    __syncthreads();
}

struct CvtTile { const float* src; bf16_t* dst; int ldn, k0, n0, mode; };
DI CvtTile cvt_desc(const Frame& F, int l, int t_) {
    const int t = __builtin_amdgcn_readfirstlane(t_);
    CvtTile c;
    if (t < 144) { const int nt_ = t >> 4, kt = t & 15; c.src = F.P->in[I_WIN] + (size_t)l * D * INW; c.ldn = INW; c.k0 = kt * 64; c.n0 = nt_ * 256; c.dst = F.WIN(); c.mode = 4; }
    else if (t < 208) { const int q = t - 144, nt_ = q >> 4, kt = q & 15; c.src = F.P->in[I_WOUT] + (size_t)l * D * D; c.ldn = D; c.k0 = kt * 64; c.n0 = nt_ * 256; c.dst = F.WOUT(); c.mode = 0; }
    else { const int q = t - 208, job = q >> 10, r = q & 1023, e = r >> 6, nt_ = (r >> 4) & 3, kt = r & 15;
        c.src = (job == 0 ? F.P->in[I_WGATE] : (job == 1 ? F.P->in[I_WUP] : F.P->in[I_WDOWN])) + (size_t)(l * NE + e) * D * D; c.ldn = D; c.k0 = kt * 64; c.n0 = nt_ * 256;
        c.dst = (bf16_t*)(job == 2 ? (unsigned char*)F.WD() + (size_t)e * D * D : (unsigned char*)F.WGU() + (size_t)e * 2 * D * D); c.mode = job + 1; }
    return c;
}
DI void cvt_load(const CvtTile& c, int tid, f32x4 (&v)[8]) {
#pragma unroll
    for (int i = 0; i < 8; ++i) { const int row = (tid >> 6) + 8 * i, c4 = (tid & 63) * 4; v[i] = *(const f32x4*)(c.src + (size_t)(c.k0 + row) * c.ldn + c.n0 + c4); }
}
DI void cvt_store(const Frame& F, const CvtTile& c, const f32x4 (&v)[8], const unsigned* colmax  ) {
    LAS float* T = (LAS float*)F.lds;
    const int tid = F.tid;
    __syncthreads();
#pragma unroll
    for (int i = 0; i < 8; ++i) { const int row = (tid >> 6) + 8 * i, c4 = (tid & 63) * 4; LAS float* tp = T + row * 257 + c4; tp[0] = v[i][0]; tp[1] = v[i][1]; tp[2] = v[i][2]; tp[3] = v[i][3]; }
    __syncthreads();
    if (c.mode == 0) {
#pragma unroll
        for (int j = 0; j < 4; ++j) { const int q = tid + NTHREADS * j, kc = q & 7, n = q >> 3; float x[8];
#pragma unroll
            for (int i = 0; i < 8; ++i) x[i] = T[(8 * kc + i) * 257 + n];
            u32x4 w; w.x = pk_bf16(x[0], x[1]); w.y = pk_bf16(x[2], x[3]); w.z = pk_bf16(x[4], x[5]); w.w = pk_bf16(x[6], x[7]);
            *(u32x4*)(c.dst + (size_t)(c.n0 + n) * D + c.k0 + 8 * kc) = w; }
    } else {
        unsigned char* d8 = (unsigned char*)c.dst;
#pragma unroll
        for (int j = 0; j < 2; ++j) { const int q = tid + NTHREADS * j, kc = q & 3, n = q >> 2; float x[16];
            const int ng = c.n0 + n; float qs = 64.0f;
            if (c.mode == 4) { const float cm = __uint_as_float(colmax[ng]); qs = cm > 0.f ? 127.0f / cm : 0.f; }
#pragma unroll
            for (int i = 0; i < 16; ++i) x[i] = T[(16 * kc + i) * 257 + n] * qs; const int drow = (c.mode == 3 || c.mode == 4) ? ng : (256 * (ng >> 7) + (ng & 127) + (c.mode == 2 ? 128 : 0));
            u32x4 w;
            if (c.mode == 4) { w.x = pk_i8x4(x[0], x[1], x[2], x[3]); w.y = pk_i8x4(x[4], x[5], x[6], x[7]); w.z = pk_i8x4(x[8], x[9], x[10], x[11]); w.w = pk_i8x4(x[12], x[13], x[14], x[15]); }
            else { w.x = pk_fp8x4(x[0], x[1], x[2], x[3]); w.y = pk_fp8x4(x[4], x[5], x[6], x[7]); w.z = pk_fp8x4(x[8], x[9], x[10], x[11]); w.w = pk_fp8x4(x[12], x[13], x[14], x[15]); }
            *(u32x4*)(d8 + (size_t)drow * D + c.k0 + 16 * kc) = w; }
    }
}
DI void convert_weights(const Frame& F0, int l) {
    const Frame F = refresh(F0);
    int t = F.bid;
    if (t < 3280) {
        f32x4 v[8]; { const CvtTile c0 = cvt_desc(F, l, t); cvt_load(c0, F.tid, v); }
        for (;;) {
            const int tn = t + F.G; const bool more = tn < 3280;
            f32x4 nv[8]; { const CvtTile nxt = cvt_desc(F, l, more ? tn : t); cvt_load(nxt, F.tid, nv); }
            asm volatile("" ::: "memory");
            { const CvtTile cur = cvt_desc(F, l, t); cvt_store(F, cur, v, F.wmax() + l * INW); }
            if (!more) break;
#pragma unroll
            for (int i = 0; i < 8; ++i) v[i] = nv[i];
            t = tn;
        }
    }
    __syncthreads();
}

template <bool X32> struct XRaw;
template <> struct XRaw<true>  { f32x4 v[4]; };
template <> struct XRaw<false> { u32x4 v[2]; };
DI void xload(XRaw<true>& r, const void* rowp, int lane) {
#pragma unroll
    for (int j = 0; j < 4; ++j) r.v[j] = *(const f32x4*)((const float*)rowp + 16 * lane + 4 * j); }
DI void xload(XRaw<false>& r, const void* rowp, int lane) {
#pragma unroll
    for (int j = 0; j < 2; ++j) r.v[j] = *(const u32x4*)((const bf16_t*)rowp + 16 * lane + 8 * j); }
DI void xcvt(const XRaw<true>& r, f32x4 (&x)[4]) {
#pragma unroll
    for (int j = 0; j < 4; ++j) x[j] = r.v[j]; }
DI void xcvt(const XRaw<false>& r, f32x4 (&x)[4]) {
#pragma unroll
    for (int j = 0; j < 2; ++j) { x[2 * j] = (f32x4){bf_lo(r.v[j].x), bf_hi(r.v[j].x), bf_lo(r.v[j].y), bf_hi(r.v[j].y)}; x[2 * j + 1] = (f32x4){bf_lo(r.v[j].z), bf_hi(r.v[j].z), bf_lo(r.v[j].w), bf_hi(r.v[j].w)}; } }
DI void xstore_bf16(bf16_t* rowp, const f32x4 (&x)[4], int lane) {
#pragma unroll
    for (int j = 0; j < 2; ++j) { u32x4 w; w.x = pk_bf16(x[2 * j][0], x[2 * j][1]); w.y = pk_bf16(x[2 * j][2], x[2 * j][3]); w.z = pk_bf16(x[2 * j + 1][0], x[2 * j + 1][1]); w.w = pk_bf16(x[2 * j + 1][2], x[2 * j + 1][3]); *(u32x4*)(rowp + 16 * lane + 8 * j) = w; } }

DI void combine_row(f32x4 (&x)[4], unsigned mask, int selv, int lanebase, const unsigned char* YD, size_t ybase  , size_t estride, const f32x4 (&g2)[4], int lane) {
    f32x4 a[4];
#pragma unroll
    for (int j = 0; j < 4; ++j) a[j] = (f32x4){0.f, 0.f, 0.f, 0.f};
    while (mask) {
        int e[4]; float wgt[4];
        e[0] = __builtin_ctz(mask); mask &= mask - 1; wgt[0] = 1.f;
#pragma unroll
        for (int k = 1; k < 4; ++k) { if (mask) { e[k] = __builtin_ctz(mask); mask &= mask - 1; wgt[k] = 1.f; } else { e[k] = e[0]; wgt[k] = 0.f; } }
        unsigned v[4][4];
#pragma unroll
        for (int k = 0; k < 4; ++k) { const int c = __builtin_amdgcn_readlane(selv, lanebase + e[k]); const unsigned char* yp = YD + (ybase + (size_t)e[k] * estride + (size_t)c) * D + 16 * lane;
            const u32x4 q = *(const u32x4*)yp; v[k][0] = q.x; v[k][1] = q.y; v[k][2] = q.z; v[k][3] = q.w; }
#pragma unroll
        for (int k = 0; k < 4; ++k)
#pragma unroll
            for (int j = 0; j < 4; ++j) { const f32x2 lo = __builtin_amdgcn_cvt_pk_f32_fp8((int)v[k][j], false), hi = __builtin_amdgcn_cvt_pk_f32_fp8((int)v[k][j], true);
                a[j][0] += wgt[k] * lo[0]; a[j][1] += wgt[k] * lo[1]; a[j][2] += wgt[k] * hi[0]; a[j][3] += wgt[k] * hi[1]; }
    }
#pragma unroll
    for (int j = 0; j < 4; ++j) x[j] += g2[j] * a[j];
}
template <bool FIRST>
DI void phase_norm1(const Frame& F0, int l) {
    const Frame F = refresh(F0);
    const int lane = F.lane; const int gw = F.bid * 8 + F.wave, nw = F.G * 8;
    const bool fin = (l == NL);
    const int npairs = (fin ? NLAT : NTOK) / 2;
    const float* n1 = fin ? F.P->in[I_FINALG] : F.P->in[I_N1] + l * D;
    const float* const xin_lat = F.P->in[I_X]; const float* const xin_ctx = F.P->in[I_CTX]; bf16_t* const XB = F.xb();
#define XROWP(row) (FIRST ? (const void*)((row) >= NLAT ? xin_ctx + (size_t)((row) - NLAT) * D : xin_lat + (size_t)(row) * D) : (const void*)(XB + (size_t)(row) * D))
    float* const xlat = F.out(); bf16_t* const Hb = F.H(); float* const hsp = F.hs(); const unsigned char* const YD = (const unsigned char*)F.R1(); const short* const selb = F.sel(); const float* const modsb = F.mods();
    XRaw<FIRST> ra, rb; int selv = -1;
    const int per = (npairs + nw - 1) / nw, p_lo = gw * per, p_hi = (p_lo + per < npairs) ? p_lo + per : npairs;
    LAS f32x4* mv = (LAS f32x4*)(F.lds + F.wave * 12288) + lane; int curb = -1;
    if (p_lo < p_hi) { const int row = 2 * p_lo; xload(ra, XROWP(row), lane); xload(rb, XROWP(row + 1), lane);
        if (!FIRST && lane < 32) selv = (int)selb[(size_t)row * 16 + lane]; }
    for (int p = p_lo; p < p_hi; ++p) {
        const int row = 2 * p; const bool isctx = row >= NLAT; const int b = isctx ? (row - NLAT) >> 8 : row >> 11;
        f32x4 xa[4], xb[4]; xcvt(ra, xa); xcvt(rb, xb);
        const int mrow = isctx ? 32 : b;
        if (mrow != curb) {
            curb = mrow;
#pragma unroll
            for (int j = 0; j < 4; ++j) { f32x4 g = *(const f32x4*)(n1 + 16 * lane + 4 * j), sh0 = (f32x4){0.f, 0.f, 0.f, 0.f}, g20 = sh0;
                if (!fin) { const float* m = modsb + (size_t)(l * 33 + mrow) * 6144; sh0 = *(const f32x4*)(m + 16 * lane + 4 * j); g *= (*(const f32x4*)(m + 1024 + 16 * lane + 4 * j) + 1.0f); }
                if (!FIRST) { const float* mprev = modsb + (size_t)((l - 1) * 33 + mrow) * 6144 + 5 * 1024; g20 = *(const f32x4*)(mprev + 16 * lane + 4 * j) * pg8::YD_INV; }
                mv[(0 * 4 + j) * 64] = g; mv[(1 * 4 + j) * 64] = sh0; mv[(2 * 4 + j) * 64] = g20; }
        }
        unsigned ma = 0u, mb = 0u; int ea[4], eb[4]; float wa[4], wb[4]; unsigned va[4][4], vb[4][4];
        const size_t ybase = isctx ? (size_t)NXS_L + (size_t)b * CAP_C : (size_t)b * CAP_L; const size_t estride = isctx ? (size_t)NB * CAP_C : (size_t)NB * CAP_L;
        if (!FIRST) {
            const unsigned long long bal = __ballot(selv >= 0); ma = (unsigned)(bal & 0xffffull); mb = (unsigned)((bal >> 16) & 0xffffull);
#pragma unroll
            for (int k = 0; k < 4; ++k) { if (ma) { ea[k] = __builtin_ctz(ma); ma &= ma - 1; wa[k] = 1.f; } else { ea[k] = 0; wa[k] = 0.f; }
                                          if (mb) { eb[k] = __builtin_ctz(mb); mb &= mb - 1; wb[k] = 1.f; } else { eb[k] = 0; wb[k] = 0.f; } }
#pragma unroll
            for (int k = 0; k < 4; ++k) { int ca = __builtin_amdgcn_readlane(selv, ea[k]), cb = __builtin_amdgcn_readlane(selv, 16 + eb[k]); ca = ca < 0 ? 0 : ca; cb = cb < 0 ? 0 : cb;
                const unsigned char* ya = YD + (ybase + (size_t)ea[k] * estride + (size_t)ca) * D + 16 * lane; const unsigned char* yb = YD + (ybase + (size_t)eb[k] * estride + (size_t)cb) * D + 16 * lane;
                const u32x4 qa_ = *(const u32x4*)ya, qb_ = *(const u32x4*)yb; va[k][0] = qa_.x; va[k][1] = qa_.y; va[k][2] = qa_.z; va[k][3] = qa_.w; vb[k][0] = qb_.x; vb[k][1] = qb_.y; vb[k][2] = qb_.z; vb[k][3] = qb_.w; }
        }
        asm volatile("" ::: "memory");
        XRaw<FIRST> na, nb; int nsel = -1;
        { const int pn = p + 1; const int rown = 2 * (pn < p_hi ? pn : p); xload(na, XROWP(rown), lane); xload(nb, XROWP(rown + 1), lane);
          if (!FIRST && lane < 32) nsel = (int)selb[(size_t)rown * 16 + lane]; }
        asm volatile("" ::: "memory");
        if (!FIRST) {
            f32x4 g2[4];
#pragma unroll
            for (int j = 0; j < 4; ++j) g2[j] = mv[(2 * 4 + j) * 64];
            f32x4 aa[4], ab[4];
#pragma unroll
            for (int j = 0; j < 4; ++j) { aa[j] = (f32x4){0.f, 0.f, 0.f, 0.f}; ab[j] = aa[j]; }
#pragma unroll
            for (int k = 0; k < 4; ++k)
#pragma unroll
                for (int j = 0; j < 4; ++j) { const f32x2 al = __builtin_amdgcn_cvt_pk_f32_fp8((int)va[k][j], false), ah = __builtin_amdgcn_cvt_pk_f32_fp8((int)va[k][j], true), bl = __builtin_amdgcn_cvt_pk_f32_fp8((int)vb[k][j], false), bh = __builtin_amdgcn_cvt_pk_f32_fp8((int)vb[k][j], true);
                    aa[j][0] += wa[k] * al[0]; aa[j][1] += wa[k] * al[1]; aa[j][2] += wa[k] * ah[0]; aa[j][3] += wa[k] * ah[1];
                    ab[j][0] += wb[k] * bl[0]; ab[j][1] += wb[k] * bl[1]; ab[j][2] += wb[k] * bh[0]; ab[j][3] += wb[k] * bh[1]; }
#pragma unroll
            for (int j = 0; j < 4; ++j) { xa[j] += g2[j] * aa[j]; xb[j] += g2[j] * ab[j]; }
            if (ma) combine_row(xa, ma, selv, 0, YD, ybase, estride, g2, lane);
            if (mb) combine_row(xb, mb, selv, 16, YD, ybase, estride, g2, lane);
            if (!fin) { xstore_bf16(XB + (size_t)row * D, xa, lane); xstore_bf16(XB + (size_t)(row + 1) * D, xb, lane); }
        }
        float ssa = 0.f, ssb = 0.f;
#pragma unroll
        for (int j = 0; j < 4; ++j) { ssa += xa[j][0] * xa[j][0] + xa[j][1] * xa[j][1] + xa[j][2] * xa[j][2] + xa[j][3] * xa[j][3]; ssb += xb[j][0] * xb[j][0] + xb[j][1] * xb[j][1] + xb[j][2] * xb[j][2] + xb[j][3] * xb[j][3]; }
        ssa = wave_sum(ssa); ssb = wave_sum(ssb);
        const float rsa = rsqrtf(ssa * (1.0f / D) + EPS), rsb = rsqrtf(ssb * (1.0f / D) + EPS);
        if (fin) {
            float* o = xlat + (size_t)row * D;
#pragma unroll
            for (int j = 0; j < 4; ++j) { const f32x4 g = mv[(0 * 4 + j) * 64]; *(f32x4*)(o + 16 * lane + 4 * j) = xa[j] * rsa * g; *(f32x4*)(o + D + 16 * lane + 4 * j) = xb[j] * rsb * g; }
        } else {
            float ma = 0.f, mb = 0.f;
#pragma unroll
            for (int j = 0; j < 4; ++j) { const f32x4 g = mv[(0 * 4 + j) * 64], sh0 = mv[(1 * 4 + j) * 64]; const f32x4 ha = xa[j] * rsa * g + sh0, hb = xb[j] * rsb * g + sh0;
                ma = fmaxf(ma, fmaxf(fmaxf(fabsf(ha[0]), fabsf(ha[1])), fmaxf(fabsf(ha[2]), fabsf(ha[3])))); mb = fmaxf(mb, fmaxf(fmaxf(fabsf(hb[0]), fabsf(hb[1])), fmaxf(fabsf(hb[2]), fabsf(hb[3])))); }
            ma = wave_max(ma); mb = wave_max(mb);
            ma = fmaxf(ma, 1e-20f); mb = fmaxf(mb, 1e-20f);
            const float qa = 127.0f / ma, qb = 127.0f / mb;
            if (lane == 0) { hsp[row] = ma * (1.0f / 127.0f); hsp[row + 1] = mb * (1.0f / 127.0f); }
            unsigned char* hp = (unsigned char*)Hb + (size_t)row * D + 16 * lane;
            unsigned wa_[4], wb_[4];
#pragma unroll
            for (int j = 0; j < 4; ++j) { const f32x4 g = mv[(0 * 4 + j) * 64], sh0 = mv[(1 * 4 + j) * 64]; const f32x4 ha = (xa[j] * rsa * g + sh0) * qa, hb = (xb[j] * rsb * g + sh0) * qb;
                wa_[j] = pk_i8x4(ha[0], ha[1], ha[2], ha[3]); wb_[j] = pk_i8x4(hb[0], hb[1], hb[2], hb[3]); }
            *(u32x4*)hp = (u32x4){wa_[0], wa_[1], wa_[2], wa_[3]}; *(u32x4*)(hp + D) = (u32x4){wb_[0], wb_[1], wb_[2], wb_[3]};
        }
        ra = na; rb = nb;
        selv = nsel;
    }
#undef XROWP
}

DI float logits_transpose_reduce(const float (&v)[16], int lane) {
    const bool b3 = lane & 8, b2 = lane & 4;
    float a8[8], a4[4], a2[2];
#pragma unroll
    for (int i = 0; i < 8; ++i) { float x = v[i], y = v[8 + i]; swap32(x, y); a8[i] = x + y; }
#pragma unroll
    for (int i = 0; i < 4; ++i) { float x = a8[i], y = a8[4 + i]; swap16(x, y); a4[i] = x + y; }
#pragma unroll
    for (int i = 0; i < 2; ++i) { const float send = b3 ? a4[i] : a4[2 + i], keep = b3 ? a4[2 + i] : a4[i]; a2[i] = keep + dpp_mov<DPP_MIR>(send); }
    float r = (b2 ? a2[1] : a2[0]) + dpp_mov<DPP_HMIR>(b2 ? a2[0] : a2[1]);
    r += dpp_mov<DPP_X1>(r); r += dpp_mov<DPP_X2>(r);
    return r;
}
DI float xlane16_max(float v) { return wave_max(v); }
DI float xlane16_sum(float v) { return 0.25f * wave_sum(v); }

DI void router_pair(const f32x4 (&xa)[4], const f32x4 (&xb)[4], float rsa, float rsb, const LAS f32x4* mv, unsigned char* hp, const LAS float* R, int lane, float& lga, float& lgb) {
    float la[16], lb[16];
#pragma unroll
    for (int e = 0; e < 16; ++e) { la[e] = 0.f; lb[e] = 0.f; }
    const LAS f32x4* Rl = (const LAS f32x4*)R + lane;
    f32x4 ha4[4], hb4[4];
#pragma unroll
    for (int j = 0; j < 4; ++j) { const f32x4 gs = mv[(0 * 4 + j) * 64], sh = mv[(1 * 4 + j) * 64]; ha4[j] = xa[j] * rsa * gs + sh; hb4[j] = xb[j] * rsb * gs + sh; }
    { u32x4 wa_, wb_;
      wa_.x = pk_fp8x4(ha4[0][0], ha4[0][1], ha4[0][2], ha4[0][3]); wa_.y = pk_fp8x4(ha4[1][0], ha4[1][1], ha4[1][2], ha4[1][3]); wa_.z = pk_fp8x4(ha4[2][0], ha4[2][1], ha4[2][2], ha4[2][3]); wa_.w = pk_fp8x4(ha4[3][0], ha4[3][1], ha4[3][2], ha4[3][3]);
      wb_.x = pk_fp8x4(hb4[0][0], hb4[0][1], hb4[0][2], hb4[0][3]); wb_.y = pk_fp8x4(hb4[1][0], hb4[1][1], hb4[1][2], hb4[1][3]); wb_.z = pk_fp8x4(hb4[2][0], hb4[2][1], hb4[2][2], hb4[2][3]); wb_.w = pk_fp8x4(hb4[3][0], hb4[3][1], hb4[3][2], hb4[3][3]);
      *(u32x4*)hp = wa_; *(u32x4*)(hp + D) = wb_; }
    asm volatile("" ::: "memory"); __builtin_amdgcn_sched_barrier(0);
    f32x4 rv[4];
#pragma unroll
    for (int eq = 0; eq < 4; ++eq) rv[eq] = Rl[eq * 64];
#pragma unroll
    for (int j = 0; j < 4; ++j) {
        const f32x4 ha = ha4[j], hb = hb4[j];
#pragma unroll
        for (int i = 0; i < 4; ++i) { const int g = j * 4 + i; f32x4 nv[4];
#pragma unroll
            for (int eq = 0; eq < 4; ++eq) nv[eq] = Rl[(((g + 1) & 15) * 4 + eq) * 64];
            __builtin_amdgcn_sched_barrier(0);
#pragma unroll
            for (int eq = 0; eq < 4; ++eq) { la[4 * eq + 0] += ha[i] * rv[eq][0]; la[4 * eq + 1] += ha[i] * rv[eq][1]; la[4 * eq + 2] += ha[i] * rv[eq][2]; la[4 * eq + 3] += ha[i] * rv[eq][3];
                                             lb[4 * eq + 0] += hb[i] * rv[eq][0]; lb[4 * eq + 1] += hb[i] * rv[eq][1]; lb[4 * eq + 2] += hb[i] * rv[eq][2]; lb[4 * eq + 3] += hb[i] * rv[eq][3]; }
#pragma unroll
            for (int eq = 0; eq < 4; ++eq) rv[eq] = nv[eq];
            asm volatile("" ::: "memory"); __builtin_amdgcn_sched_barrier(0); } }
    lga = logits_transpose_reduce(la, lane); lgb = logits_transpose_reduce(lb, lane);
}
template <bool FIRST>
DI void phase_norm2_router(const Frame& F0, int l) {
    const Frame F = refresh(F0);
    const int lane = F.lane, tid = F.tid; const int gw = F.bid * 8 + F.wave, nw = F.G * 8;
    LAS float* R = (LAS float*)F.lds;
    __syncthreads();
    { const float* rw = F.P->in[I_ROUTER] + (size_t)l * D * NE;
      for (int idx = tid; idx < D * NE; idx += NTHREADS) { const int c = idx >> 4, e = idx & 15, ln = c >> 4, i = c & 3, j = (c >> 2) & 3, eq = e >> 2, ee = e & 3;
          R[((((j * 4 + i) * 4 + eq) * 64 + ln) << 2) + ee] = rw[idx]; } }
    __syncthreads();
    const int npairs = ((l == NL - 1) ? NLAT : NTOK) / 2;
    const float* n2 = F.P->in[I_N2] + l * D;
    bf16_t* const XB = F.xb(); const bf16_t* const DL = F.R1(); bf16_t* const Hb = F.H(); float* const affp = F.aff(); const float* const modsl = F.mods() + (size_t)l * 33 * 6144;
    const float* const xin_lat = F.P->in[I_X]; const float* const xin_ctx = F.P->in[I_CTX];
#define XROWP(row) (FIRST ? (const void*)((row) >= NLAT ? xin_ctx + (size_t)((row) - NLAT) * D : xin_lat + (size_t)(row) * D) : (const void*)(XB + (size_t)(row) * D))
    XRaw<FIRST> ra, rb; XRaw<false> da, db;
    const int per = (npairs + nw - 1) / nw, p_lo = gw * per, p_hi = (p_lo + per < npairs) ? p_lo + per : npairs;
    LAS f32x4* mv = (LAS f32x4*)(F.lds + 65536 + F.wave * 8192) + lane; int curb = -1;
    if (p_lo < p_hi) { const int row = 2 * p_lo; xload(ra, XROWP(row), lane); xload(rb, XROWP(row + 1), lane); xload(da, DL + (size_t)row * D, lane); xload(db, DL + (size_t)(row + 1) * D, lane); }
    for (int p = p_lo; p < p_hi; ++p) {
        const int row = 2 * p; const bool isctx = row >= NLAT; const int b = isctx ? (row - NLAT) >> 8 : row >> 11; const int t = isctx ? (row - NLAT) & 255 : row & 2047;
        f32x4 xa[4], xb[4]; xcvt(ra, xa); xcvt(rb, xb);
        { f32x4 ta[4], tb[4]; xcvt(da, ta); xcvt(db, tb);
#pragma unroll
          for (int j = 0; j < 4; ++j) { xa[j] += ta[j]; xb[j] += tb[j]; } }
        xstore_bf16(XB + (size_t)row * D, xa, lane); xstore_bf16(XB + (size_t)(row + 1) * D, xb, lane);
        const int mrow = isctx ? 32 : b;
        if (mrow != curb) { curb = mrow; const float* m = modsl + (size_t)mrow * 6144 + 3 * 1024;
#pragma unroll
            for (int j = 0; j < 4; ++j) { mv[(1 * 4 + j) * 64] = *(const f32x4*)(m + 16 * lane + 4 * j); mv[(0 * 4 + j) * 64] = (*(const f32x4*)(m + 1024 + 16 * lane + 4 * j) + 1.0f) * *(const f32x4*)(n2 + 16 * lane + 4 * j); } }
        XRaw<FIRST> na, nb; XRaw<false> dna, dnb;
        { const int pn = p + 1; const int rown = 2 * (pn < p_hi ? pn : p); xload(na, XROWP(rown), lane); xload(nb, XROWP(rown + 1), lane); xload(dna, DL + (size_t)rown * D, lane); xload(dnb, DL + (size_t)(rown + 1) * D, lane); }
        asm volatile("" ::: "memory");
        float ssa = 0.f, ssb = 0.f;
#pragma unroll
        for (int j = 0; j < 4; ++j) { ssa += xa[j][0] * xa[j][0] + xa[j][1] * xa[j][1] + xa[j][2] * xa[j][2] + xa[j][3] * xa[j][3]; ssb += xb[j][0] * xb[j][0] + xb[j][1] * xb[j][1] + xb[j][2] * xb[j][2] + xb[j][3] * xb[j][3]; }
        ssa = wave_sum(ssa); ssb = wave_sum(ssb);
        const float rsa = rsqrtf(ssa * (1.0f / D) + EPS), rsb = rsqrtf(ssb * (1.0f / D) + EPS);
        unsigned char* hp = (unsigned char*)Hb + (size_t)row * D + 16 * lane;
        float lga, lgb; router_pair(xa, xb, rsa, rsb, mv, hp, R, lane, lga, lgb);
        __builtin_amdgcn_sched_barrier(0);
        const float ea = __expf(lga - xlane16_max(lga)), eb = __expf(lgb - xlane16_max(lgb));
        const float pa = ea / xlane16_sum(ea), pb = eb / xlane16_sum(eb);
        if ((lane & 3) == 0) { const int e = lane >> 2; float* ap = isctx ? affp + (size_t)NB * NE * SEQ + (size_t)(b * NE + e) * CTX + t : affp + (size_t)(b * NE + e) * SEQ + t; ap[0] = pa; ap[1] = pb; }
        ra = na; rb = nb; da = dna; db = dnb;
    }
#undef XROWP
    __syncthreads();
}

typedef unsigned long long u64;
DI void cmpx(u64& a, u64& b, bool desc) { const bool sw = desc ? (a < b) : (a > b); const u64 t = sw ? b : a; b = sw ? a : b; a = t; }
template <int N  >
DI void bitonic4(u64 (&k)[4], int t, int lane, LAS u64* xbuf  ) {
    int lpass = 0;
    for (int k2 = 2; k2 <= N; k2 <<= 1) {
        for (int j = k2 >> 1; j > 0; j >>= 1) {
            if (j >= 256) {
                if (N > 256) {
                    LAS u64* xb = xbuf + (lpass & 1) * 2048; ++lpass;
                    *(LAS u32x4*)(xb + 4 * t) = __builtin_bit_cast(u32x4, (unsigned long long __attribute__((ext_vector_type(2)))){k[0], k[1]});
                    *(LAS u32x4*)(xb + 4 * t + 2) = __builtin_bit_cast(u32x4, (unsigned long long __attribute__((ext_vector_type(2)))){k[2], k[3]});
                    __syncthreads();
                    const int p = t ^ (j >> 2); const bool lower = (t & (j >> 2)) == 0, up = ((4 * t) & k2) == 0;
                    const u32x4 q0 = *(const LAS u32x4*)(xb + 4 * p), q1 = *(const LAS u32x4*)(xb + 4 * p + 2);
                    const u64 b[4] = {((u64)q0.y << 32) | q0.x, ((u64)q0.w << 32) | q0.z, ((u64)q1.y << 32) | q1.x, ((u64)q1.w << 32) | q1.z};
#pragma unroll
                    for (int e = 0; e < 4; ++e) { const u64 mx = k[e] > b[e] ? k[e] : b[e], mn = k[e] > b[e] ? b[e] : k[e]; k[e] = (lower == up) ? mx : mn; }
                }
            } else if (j >= 4) {
                const int m = j >> 2; const bool lower = (t & m) == 0, up = ((4 * t) & k2) == 0;
#pragma unroll
                for (int e = 0; e < 4; ++e) { const unsigned lo = (unsigned)k[e], hi = (unsigned)(k[e] >> 32);
                    const u64 b = ((u64)(unsigned)__shfl_xor((int)hi, m) << 32) | (unsigned)__shfl_xor((int)lo, m);
                    const u64 mx = k[e] > b ? k[e] : b, mn = k[e] > b ? b : k[e]; k[e] = (lower == up) ? mx : mn; }
            } else if (j == 2) {
                const bool up = ((4 * t) & k2) == 0 || k2 < 4;
                const bool up4 = (k2 == 4) ? ((t & 1) == 0) : (((4 * t) & k2) == 0);
                (void)up; cmpx(k[0], k[2], up4); cmpx(k[1], k[3], up4);
            } else {
                if (k2 == 2) { cmpx(k[0], k[1], true); cmpx(k[2], k[3], false); }
                else { const bool up4 = (k2 == 4) ? ((t & 1) == 0) : (((4 * t) & k2) == 0); cmpx(k[0], k[1], up4); cmpx(k[2], k[3], up4); }
            }
        }
    }
}
DI void topk_emit(const Frame& F, const u64 (&k)[4], int t, bool isctx, int b, int e, int T, int cap) {
    const size_t rowbase = isctx ? (size_t)NXS_L + (size_t)(e * NB + b) * CAP_C : (size_t)(e * NB + b) * CAP_L;
    short* sp = F.sel() + (isctx ? (size_t)NLAT * 16 + (size_t)b * CTX * 16 : (size_t)b * SEQ * 16) + e;
#pragma unroll
    for (int q = 0; q < 4; ++q) { const int pos = 4 * t + q; const int tok = T - 1 - (int)(unsigned)(k[q] & 0xffffffffull);
        sp[(size_t)tok * 16] = (short)(pos < cap ? pos : -1);
        if (pos < cap) { F.gate()[rowbase + pos] = __uint_as_float((unsigned)(k[q] >> 32)); F.idx()[rowbase + pos] = (isctx ? NLAT + b * CTX : b * SEQ) + tok; } }
}
DI void wg_prefix4(const int (&f)[4], int (&out)[4], LAS unsigned* wtot, int lane, int w) {
    int below = 0, tot = 0;
#pragma unroll
    for (int q = 0; q < 4; ++q) { const u64 m = __ballot(f[q] != 0); below += (int)__builtin_amdgcn_mbcnt_hi((unsigned)(m >> 32), __builtin_amdgcn_mbcnt_lo((unsigned)m, 0u)); tot += __popcll(m); }
    if (lane == 0) wtot[w] = (unsigned)tot;
    __syncthreads();
    int run = below;
#pragma unroll
    for (int i = 0; i < 8; ++i) run += (i < w) ? (int)wtot[i] : 0;
#pragma unroll
    for (int q = 0; q < 4; ++q) { out[q] = run; run += f[q]; }
}
DI void topk_select2048(const Frame& F, const float* ap, int b, int e) {
    const int tid = F.tid, lane = F.lane, w = F.wave;
    LAS unsigned* hist = (LAS unsigned*)F.lds;
    LAS unsigned* wtot = hist + 3072;
    const f32x4 a4 = *(const f32x4*)(ap + 4 * tid);
#pragma unroll
    for (int i = 0; i < 6; ++i) hist[tid + NTHREADS * i] = 0u;
    unsigned key[4];
    unsigned kclamp, kmask; int need;
    asm volatile("s_mov_b32 %0, 0x3fffffff\n\ts_mov_b32 %1, 0x3ff\n\ts_movk_i32 %2, 0x100" : "=s"(kclamp), "=s"(kmask), "=s"(need));
#pragma unroll
    for (int q = 0; q < 4; ++q) { const unsigned u = __float_as_uint(a4[q]); key[q] = u < kclamp ? u : kclamp; }
    __syncthreads();
    unsigned prefix = 0u; int eqc = 0;
#pragma unroll
    for (int p = 0; p < 3; ++p) {
        const int sh = 20 - 10 * p;
        LAS unsigned* h = hist + 1024 * p;
#pragma unroll
        for (int q = 0; q < 4; ++q) if (p == 0 || (key[q] >> (sh + 10)) == prefix) __hip_atomic_fetch_add(h + ((key[q] >> sh) & kmask), 1u, __ATOMIC_RELAXED, __HIP_MEMORY_SCOPE_WORKGROUP);
        __syncthreads();
        unsigned c[16];
#pragma unroll
        for (int i = 0; i < 4; ++i) { const u32x4 v = *(const LAS u32x4*)(h + 16 * lane + 4 * i); c[4 * i] = v.x; c[4 * i + 1] = v.y; c[4 * i + 2] = v.z; c[4 * i + 3] = v.w; }
        int s = 0;
#pragma unroll
        for (int i = 0; i < 16; ++i) s += (int)c[i];
        int incl = s;
#pragma unroll
        for (int d = 1; d < 64; d <<= 1) { const int t = __shfl_down(incl, d); incl += (lane + d < 64) ? t : 0; }
        const int S = incl - s;
        int bin = -1, above = 0, cnt = 0, run = S;
#pragma unroll
        for (int i = 15; i >= 0; --i) { const bool take = (bin < 0) && (run + (int)c[i] >= need); above = take ? run : above; cnt = take ? (int)c[i] : cnt; bin = take ? i : bin; run += (int)c[i]; }
        const bool hit = (S < need) && (bin >= 0);
        const int src = __ffsll((long long)__ballot(hit)) - 1;
        const int dsel = __shfl(16 * lane + bin, src); above = __shfl(above, src); eqc = __shfl(cnt, src);
        prefix = (prefix << 10) | (unsigned)dsel; need -= above;
    }
    int sl[4], eq[4];
#pragma unroll
    for (int q = 0; q < 4; ++q) { sl[q] = key[q] > prefix ? 1 : 0; eq[q] = key[q] == prefix ? 1 : 0; }
    if (eqc != need) {
        int er[4]; wg_prefix4(eq, er, wtot, lane, w);
#pragma unroll
        for (int q = 0; q < 4; ++q) eq[q] = (eq[q] && er[q] < need) ? 1 : 0;
    }
#pragma unroll
    for (int q = 0; q < 4; ++q) sl[q] |= eq[q];
    int pos[4]; wg_prefix4(sl, pos, wtot + 8, lane, w);
    const size_t rowbase = (size_t)(e * NB + b) * CAP_L;
    short* sp = F.sel() + (size_t)b * SEQ * 16 + e;
#pragma unroll
    for (int q = 0; q < 4; ++q) { const int tok = 4 * tid + q;
        sp[(size_t)tok * 16] = (short)(sl[q] ? pos[q] : -1);
        if (sl[q]) { F.gate()[rowbase + pos[q]] = a4[q]; F.idx()[rowbase + pos[q]] = b * SEQ + tok; } }
}
DI void phase_topk(const Frame& F0, int l) {
    const Frame F = refresh(F0);
    const int tid = F.tid, lane = F.lane, w = F.wave;
    LAS u64* xbuf = (LAS u64*)F.lds;
    __syncthreads();
    for (int u = F.bid; u < NB * NE; u += F.G) {
        const int b = u >> 4, e = u & 15;
        topk_select2048(F, F.aff() + (size_t)u * SEQ, b, e);
        __syncthreads();
    }
    if (l < NL - 1) {
        for (int u = F.bid * 8 + w; u < NB * NE; u += F.G * 8) {
            const int b = u >> 4, e = u & 15;
            const float* ap = F.aff() + (size_t)NB * NE * SEQ + (size_t)u * CTX;
            u64 k[4];
            { const f32x4 a4 = *(const f32x4*)(ap + 4 * lane);
#pragma unroll
              for (int q = 0; q < 4; ++q) k[q] = ((u64)__float_as_uint(a4[q]) << 32) | (unsigned)(CTX - 1 - (4 * lane + q)); }
            bitonic4<256>(k, lane, lane, xbuf);
            topk_emit(F, k, lane, true, b, e, CTX, CAP_C);
        }
    }
    __syncthreads();
}

DI void phase_prep(const Frame& F0, int l) {
    const Frame F = refresh(F0);
    const int tid = F.tid, lane = F.lane, w = F.wave;
    constexpr int UROWS = 62, U_BYTES = UROWS * 1024, WP_BYTES = 37 * 1024, VS_OFF = U_BYTES + WP_BYTES, RP_OFF = VS_OFF + 16640;
    LAS float* U = (LAS float*)F.lds; LAS float* Wp = (LAS float*)(F.lds + U_BYTES); LAS unsigned char* VS = F.lds + VS_OFF; LAS float* RP = (LAS float*)(F.lds + RP_OFF);
    const bf16_t* P = F.R1();
    bf16_t* const Yb = F.Y();
    __syncthreads();
    { const float* cb = F.P->in[I_CBW] + (size_t)l * 31 * 256; for (int i = tid; i < 37 * 256; i += NTHREADS) { const int k = (i >> 8) - 3; Wp[i] = (k >= 0 && k < 31) ? cb[k * 256 + (i & 255)] : 0.f; } }
    const f32x4 cbias = *(const f32x4*)(F.P->in[I_CBB] + l * 256 + 4 * lane), lng = *(const f32x4*)(F.P->in[I_CLNG] + l * 256 + 4 * lane), lnb = *(const f32x4*)(F.P->in[I_CLNB] + l * 256 + 4 * lane);
    f32x4 wa[3];
#pragma unroll
    for (int k = 0; k < 3; ++k) wa[k] = *(const f32x4*)(F.P->in[I_CAW] + (size_t)(l * 3 + k) * 256 + 4 * lane);
    const int hd = lane >> 2, sub = lane & 3, half = sub >> 1, qq = sub & 1;
    const int hdc = hd < 12 ? hd : 11;
    const int srccol = hdc < 4 ? 1280 + 64 * hdc : (hdc < 6 ? 1536 + 64 * (hdc - 4) : (hdc < 10 ? 1792 + 64 * (hdc - 6) : 2048 + 64 * (hdc - 10)));
    const bool isq = hdc < 4 || (hdc >= 6 && hdc < 10), isD = hdc >= 6;
    const int c1 = srccol + 32 * half + 8 * qq;
    float g1v[8], g2v[8];
    { const float* gg = (isq ? F.P->in[I_QNG] : F.P->in[I_KNG]) + l * 64 + 32 * half + 8 * qq;
#pragma unroll
      for (int i = 0; i < 8; ++i) { g1v[i] = isD ? gg[i] : 1.0f; g2v[i] = isD ? gg[16 + i] : 1.0f; } }
    const float qscale = isq ? 0.125f * LOG2E : 1.0f;
    { const float* const ropet = F.rope(); for (int i = tid; i < 64 * 16 * 2; i += NTHREADS) RP[i] = ropet[i]; }

    u32x2 bvr[8], bgr[8]; u32x4 vr[2];
#define PREP_LOAD_A(uu) do { const bool ic_ = (uu) >= 2048; const int b_ = ic_ ? ((uu) - 2048) >> 3 : (uu) >> 6, ch_ = ic_ ? ((uu) - 2048) & 7 : (uu) & 63, T_ = ic_ ? CTX : SEQ, t0_ = ch_ * 32; \
        const size_t rb_ = ic_ ? (size_t)NLAT + (size_t)b_ * CTX : (size_t)b_ * SEQ; \
        _Pragma("unroll") for (int it = 0; it < 8; ++it) { const int idx = tid + NTHREADS * it, rr = idx >> 6, c4 = (idx & 63) * 4; int t = t0_ - 15 + rr; t = t < 0 ? 0 : (t > T_ - 1 ? T_ - 1 : t); \
            const bf16_t* pr = P + (rb_ + t) * INW; bvr[it] = *(const u32x2*)(pr + 768 + c4); bgr[it] = *(const u32x2*)(pr + 1024 + c4); } \
        _Pragma("unroll") for (int it = 0; it < 2; ++it) { const int idx = tid + NTHREADS * it, tl = idx >> 5, c16 = idx & 31, vc = 8 * c16; const int pc = vc < 128 ? 1664 + vc : 2176 + (vc - 128); \
            vr[it] = *(const u32x4*)(P + (rb_ + t0_ + tl) * INW + pc); } } while (0)
    if (F.bid < 2304) PREP_LOAD_A(F.bid);
    for (int u = F.bid; u < 2304; u += F.G) {
        const bool isctx = u >= 2048; const int b = isctx ? (u - 2048) >> 3 : u >> 6; const int ch = isctx ? (u - 2048) & 7 : u & 63;
        const int T = isctx ? CTX : SEQ, t0 = ch * 32; const size_t rowbase = isctx ? (size_t)NLAT + (size_t)b * CTX : (size_t)b * SEQ;
        const int posbase = isctx ? SEQ : 0;
        __syncthreads();
        {
#pragma unroll
            for (int it = 0; it < 8; ++it) { const int idx = tid + NTHREADS * it, rr = idx >> 6, c4 = (idx & 63) * 4, t = t0 - 15 + rr; const bool inr = t >= 0 && t < T; const u32x2 bv = bvr[it], bg = bgr[it]; f32x4 uv;
                uv[0] = bf_lo(bv.x) * fast_sigmoid(bf_lo(bg.x)); uv[1] = bf_hi(bv.x) * fast_sigmoid(bf_hi(bg.x)); uv[2] = bf_lo(bv.y) * fast_sigmoid(bf_lo(bg.y)); uv[3] = bf_hi(bv.y) * fast_sigmoid(bf_hi(bg.y));
                if (!inr) uv = (f32x4){0.f, 0.f, 0.f, 0.f};
                if (rr < UROWS) *(LAS f32x4*)(U + rr * 256 + c4) = uv; }
#pragma unroll
            for (int it = 0; it < 2; ++it) { const int idx = tid + NTHREADS * it, tl = idx >> 5, c16 = idx & 31; LAS unsigned* dp = (LAS unsigned*)(VS + tl * 516 + 16 * c16); dp[0] = vr[it].x; dp[1] = vr[it].y; dp[2] = vr[it].z; dp[3] = vr[it].w; }
        }
        __syncthreads();
        const int tb = t0 + 4 * w;
        u32x2 acr[6], ahr[6], abr[4]; u32x4 ra[4], rb[4];
#pragma unroll
        for (int rr = 0; rr < 6; ++rr) { int t = tb - 1 + rr; t = t < 0 ? 0 : (t > T - 1 ? T - 1 : t);
            const bf16_t* pr = P + (rowbase + t) * INW; acr[rr] = *(const u32x2*)(pr + 256 + 4 * lane); ahr[rr] = *(const u32x2*)(pr + 512 + 4 * lane); }
#pragma unroll
        for (int jj = 0; jj < 4; ++jj) { const bf16_t* pr = P + (rowbase + tb + jj) * INW; abr[jj] = *(const u32x2*)(pr + 4 * lane);
            ra[jj] = *(const u32x4*)(pr + c1); rb[jj] = *(const u32x4*)(pr + c1 + 16); }
        asm volatile("" ::: "memory");
        { const int un = (u + F.G < 2304) ? u + F.G : u; PREP_LOAD_A(un); }
        asm volatile("" ::: "memory");
        {
            const int tl0 = 4 * w;
            f32x4 acc0 = cbias, acc1 = cbias, acc2 = cbias, acc3 = cbias;
            f32x4 w1 = (f32x4){0.f, 0.f, 0.f, 0.f}, w2 = w1, w3 = w1;
            const LAS float* up = U + tl0 * 256 + 4 * lane; const LAS float* wp = Wp + 3 * 256 + 4 * lane;
#pragma unroll 2
            for (int r = 0; r < 34; ++r) { const f32x4 uu = *(const LAS f32x4*)(up + r * 256); const f32x4 w0 = *(const LAS f32x4*)(wp + r * 256);
                acc0 += w0 * uu; acc1 += w1 * uu; acc2 += w2 * uu; acc3 += w3 * uu; w3 = w2; w2 = w1; w1 = w0; }
            f32x4 accs[4] = {acc0, acc1, acc2, acc3};
#pragma unroll
            for (int jj = 0; jj < 4; ++jj) { const f32x4 a = accs[jj];
                const float mu = wave_sum(a[0] + a[1] + a[2] + a[3]) * (1.0f / 256.0f);
                const f32x4 dlt = a - mu;
                const float var = wave_sum(dlt[0] * dlt[0] + dlt[1] * dlt[1] + dlt[2] * dlt[2] + dlt[3] * dlt[3]) * (1.0f / 256.0f);
                const float rs = rsqrtf(var + EPS);
                f32x4 y = dlt * rs * lng + lnb;
#pragma unroll
                for (int i = 0; i < 4; ++i) y[i] = y[i] * fast_sigmoid(y[i]);
                u32x2 o; o.x = pk_bf16(y[0], y[1]); o.y = pk_bf16(y[2], y[3]);
                *(u32x2*)(Yb + (rowbase + tb + jj) * D + 256 + 4 * lane) = o; }
        }
#pragma unroll
        for (int j = 0; j < 2; ++j) { const int q = tid + NTHREADS * j, tq = q & 3, vc = q >> 2; unsigned e8[8];
#pragma unroll
            for (int i = 0; i < 8; ++i) e8[i] = *(const LAS unsigned short*)(VS + (8 * tq + i) * 516 + 2 * vc);
            u32x4 o; o.x = e8[0] | (e8[1] << 16); o.y = e8[2] | (e8[3] << 16); o.z = e8[4] | (e8[5] << 16); o.w = e8[6] | (e8[7] << 16);
            const int grp = vc >> 7, kvh = (vc >> 6) & 1, d = vc & 63;
            bf16_t* dp = (grp ? F.VDT() : F.VCT()) + ((size_t)(b * 2 + kvh) * HD + d) * KPOS + posbase + t0 + 8 * tq;
            *(u32x4*)dp = o; }
        __builtin_amdgcn_sched_barrier(0);
        {
            f32x4 chv[6];
#pragma unroll
            for (int rr = 0; rr < 6; ++rr) { const u32x2 ac = acr[rr], ah = ahr[rr]; chv[rr] = (f32x4){bf_lo(ac.x) * bf_lo(ah.x), bf_hi(ac.x) * bf_hi(ah.x), bf_lo(ac.y) * bf_lo(ah.y), bf_hi(ac.y) * bf_hi(ah.y)}; }
            if (tb == 0) chv[0] = (f32x4){0.f, 0.f, 0.f, 0.f};
            if (tb + 4 == T) chv[5] = (f32x4){0.f, 0.f, 0.f, 0.f};
#pragma unroll
            for (int jj = 0; jj < 4; ++jj) { const size_t row = rowbase + tb + jj; const u32x2 ab = abr[jj];
                const f32x4 cv = wa[0] * chv[jj] + wa[1] * chv[jj + 1] + wa[2] * chv[jj + 2];
                u32x2 o; o.x = pk_bf16(bf_lo(ab.x) * cv[0], bf_hi(ab.x) * cv[1]); o.y = pk_bf16(bf_lo(ab.y) * cv[2], bf_hi(ab.y) * cv[3]);
                *(u32x2*)(Yb + row * D + 4 * lane) = o; }
        }
        __builtin_amdgcn_sched_barrier(0);
        if (lane < 48) {
#pragma unroll
            for (int jj = 0; jj < 4; ++jj) { const int t = tb + jj; const size_t row = rowbase + t;
                const u32x4 r1 = ra[jj], r2 = rb[jj];
                float x1[8], x2[8];
                x1[0] = bf_lo(r1.x); x1[1] = bf_hi(r1.x); x1[2] = bf_lo(r1.y); x1[3] = bf_hi(r1.y); x1[4] = bf_lo(r1.z); x1[5] = bf_hi(r1.z); x1[6] = bf_lo(r1.w); x1[7] = bf_hi(r1.w);
                x2[0] = bf_lo(r2.x); x2[1] = bf_hi(r2.x); x2[2] = bf_lo(r2.y); x2[3] = bf_hi(r2.y); x2[4] = bf_lo(r2.z); x2[5] = bf_hi(r2.z); x2[6] = bf_lo(r2.w); x2[7] = bf_hi(r2.w);
                float ss = 0.f;
#pragma unroll
                for (int i = 0; i < 8; ++i) ss += x1[i] * x1[i] + x2[i] * x2[i];
                ss += dpp_mov<DPP_X1>(ss); ss += dpp_mov<DPP_X2>(ss);
                const float rstd = isD ? rsqrtf(ss * (1.0f / 64.0f) + EPS) : 1.0f;
#pragma unroll
                for (int i = 0; i < 8; ++i) { x1[i] = x1[i] * rstd * g1v[i]; x2[i] = x2[i] * rstd * g2v[i]; }
                if (!isctx) { const int pos = half ? (t & 63) : (t >> 6); const LAS float* rp = RP + (pos * 16 + 8 * qq) * 2;
#pragma unroll
                    for (int i = 0; i < 8; ++i) { const float c = rp[2 * i], sn = rp[2 * i + 1]; const float o1 = x1[i] * c - x2[i] * sn, o2 = x2[i] * c + x1[i] * sn; x1[i] = o1; x2[i] = o2; } }
                u32x4 w1, w2;
                w1.x = pk_bf16(x1[0] * qscale, x1[1] * qscale); w1.y = pk_bf16(x1[2] * qscale, x1[3] * qscale); w1.z = pk_bf16(x1[4] * qscale, x1[5] * qscale); w1.w = pk_bf16(x1[6] * qscale, x1[7] * qscale);
                w2.x = pk_bf16(x2[0] * qscale, x2[1] * qscale); w2.y = pk_bf16(x2[2] * qscale, x2[3] * qscale); w2.z = pk_bf16(x2[4] * qscale, x2[5] * qscale); w2.w = pk_bf16(x2[6] * qscale, x2[7] * qscale);
                bf16_t* dp;
                if (isq) { const int hq = isD ? hdc - 6 : hdc; dp = (isD ? F.QD() : F.QC()) + row * 256 + hq * 64 + 32 * half + 8 * qq; }
                else { const int kvh = isD ? hdc - 10 : hdc - 4; dp = (isD ? F.KD() : F.KC()) + ((size_t)(b * 2 + kvh) * KPOS + posbase + t) * HD + 32 * half + 8 * qq; }
                *(u32x4*)dp = w1; *(u32x4*)(dp + 16) = w2; }
        }
    }
    __syncthreads();
}

constexpr int KT_STRIDE = 144, VT_STRIDE = 264, KT_BYTES = 128 * KT_STRIDE, VT_BYTES = 64 * VT_STRIDE, KV_BUF = KT_BYTES + VT_BYTES;
#ifndef GEMM_STAGGER
#define GEMM_STAGGER 0
#endif
#ifndef ATT_STAGGER
#define ATT_STAGGER 6
#endif
constexpr float ATT_THR = 6.0f;
struct AUnit { const bf16_t* Q; const bf16_t* K; const bf16_t* Vt; size_t qrow0; int kvh, jt0h, nloc2, nt2, qpos0, ycol; bool masked, use_sink, isD; };
DI AUnit attn_desc(const Frame& F, int u) {
    AUnit a; int b, qb;
    if (u < 1024) { b = u >> 5; a.kvh = (u >> 4) & 1; qb = u & 15; a.isD = true; a.jt0h = 0; a.nloc2 = 18; a.nt2 = 18; a.masked = false; a.qpos0 = 0; a.qrow0 = (size_t)b * SEQ + 128 * qb; }
    else if (u < 2048) { const int v = u - 1024; b = v >> 5; a.kvh = (v >> 4) & 1; qb = v & 15; a.isD = false; a.jt0h = qb > 0 ? qb - 1 : 0; a.nloc2 = (qb < 15 ? qb + 2 : 16) - a.jt0h; a.nt2 = a.nloc2 + 2; a.masked = true; a.qpos0 = 128 * qb; a.qrow0 = (size_t)b * SEQ + 128 * qb; }
    else { const int v = u - 2048; b = v >> 3; a.isD = (v >> 2) & 1; a.kvh = (v >> 1) & 1; qb = v & 1; a.jt0h = 0; a.nloc2 = 0; a.nt2 = 2; a.masked = false; a.qpos0 = 0; a.qrow0 = (size_t)NLAT + (size_t)b * CTX + 128 * qb; }
    a.Q = a.isD ? F.QD() : F.QC();
    a.K = (a.isD ? F.KD() : F.KC()) + (size_t)(b * 2 + a.kvh) * KPOS * HD; a.Vt = (a.isD ? F.VDT() : F.VCT()) + (size_t)(b * 2 + a.kvh) * HD * KPOS;
    a.use_sink = !a.isD; a.ycol = a.isD ? 768 : 512;
    return a;
}
#define ATT_SB() __builtin_amdgcn_sched_barrier(0)
template <bool NOMAX>
DI void attn_softmax(f32x16& s0, f32x16& o0, f32x16& o1, f32x16& negm, float& m, float& lsum, bf16x8 (&pf)[2], bool domask, int klo, int qpos0, int qr, int h) {
    if (!NOMAX) {
        if (domask) { const int kp0 = klo + 4 * h, qp = qpos0 + qr;
            if (klo < qpos0 - 1 || klo + 31 > qpos0 + 128) {
#pragma unroll
                for (int i = 0; i < 16; ++i) { const int kp = kp0 + (i & 3) + 8 * (i >> 2); const int d0 = qp - kp; s0[i] = (d0 > 128 || d0 < -128) ? -1e30f : s0[i]; } } }
        float mx = fmaxf(fmaxf(s0[0], s0[1]), fmaxf(s0[2], s0[3]));
#pragma unroll
        for (int i = 4; i < 16; i += 4) mx = fmaxf(mx, fmaxf(fmaxf(s0[i], s0[i + 1]), fmaxf(s0[i + 2], s0[i + 3])));
        mx = xor32_max(mx);
        if (__any(mx > ATT_THR)) {
            const float delta = fmaxf(mx, 0.0f), alpha = __builtin_amdgcn_exp2f(-delta);
            m += delta; lsum *= alpha;
#pragma unroll
            for (int i = 0; i < 16; ++i) { o0[i] *= alpha; o1[i] *= alpha; s0[i] -= delta; negm[i] = -m; }
        }
    }
    float ps = 0.f;
#pragma unroll
    for (int i = 0; i < 16; ++i) { s0[i] = __builtin_amdgcn_exp2f(s0[i]); ps += s0[i]; }
    lsum += ps;
    f32x8 t0, t1;
#pragma unroll
    for (int i = 0; i < 8; ++i) { t0[i] = s0[i]; t1[i] = s0[8 + i]; }
    pf[0] = __builtin_bit_cast(bf16x8, __builtin_convertvector(t0, bfv8)); pf[1] = __builtin_bit_cast(bf16x8, __builtin_convertvector(t1, bfv8));
}
template <bool NOMAX>
DI void attn_tile(LAS unsigned char* kb_, LAS unsigned char* vb_, const bf16x8 (&qf)[4], f32x16& o0, f32x16& o1, f32x16& negm, float& m, float& lsum,
                  bool domask, int klo0  , int qpos0, int qr, int r, int h) {
    bf16x8 ka[4]; u32x2 vl[2][2], vh[2][2]; f32x16 s0; bf16x8 pf[2];
#define ATT_KLOAD(st) do { _Pragma("unroll") for (int ks = 0; ks < 4; ++ks) ka[ks] = *(const LAS bf16x8*)(kb_ + (32 * (st) + r) * KT_STRIDE + 32 * ks + 16 * h); } while (0)
    ATT_KLOAD(0);
#pragma unroll
    for (int st = 0; st < 4; ++st) {
        ATT_SB();
        if (NOMAX) {
#pragma unroll
            for (int i = 0; i < 16; ++i) s0[i] = 0.f;
        } else s0 = negm;
#pragma unroll
        for (int ks = 0; ks < 4; ++ks) s0 = __builtin_amdgcn_mfma_f32_32x32x16_bf16(ka[ks], qf[ks], s0, 0, 0, 0);
        ATT_SB();
#pragma unroll
        for (int db = 0; db < 2; ++db)
#pragma unroll
            for (int s2 = 0; s2 < 2; ++s2) { const int kbyte = 2 * (32 * st + 16 * s2 + 4 * h); vl[db][s2] = *(const LAS u32x2*)(vb_ + (32 * db + r) * VT_STRIDE + kbyte); vh[db][s2] = *(const LAS u32x2*)(vb_ + (32 * db + r) * VT_STRIDE + kbyte + 16); }
        ATT_SB();
        attn_softmax<NOMAX>(s0, o0, o1, negm, m, lsum, pf, domask, klo0 + 32 * st, qpos0, qr, h);
        ATT_SB();
        if (st < 3) ATT_KLOAD(st + 1);
        ATT_SB();
#pragma unroll
        for (int s2 = 0; s2 < 2; ++s2) {
            const bf16x8 va0 = __builtin_bit_cast(bf16x8, (u32x4){vl[0][s2].x, vl[0][s2].y, vh[0][s2].x, vh[0][s2].y}), va1 = __builtin_bit_cast(bf16x8, (u32x4){vl[1][s2].x, vl[1][s2].y, vh[1][s2].x, vh[1][s2].y});
            o0 = __builtin_amdgcn_mfma_f32_32x32x16_bf16(va0, pf[s2], o0, 0, 0, 0); o1 = __builtin_amdgcn_mfma_f32_32x32x16_bf16(va1, pf[s2], o1, 0, 0, 0); }
    }
    ATT_SB();
#undef ATT_KLOAD
}
template <bool NOMAX>
DI void attn_run(const Frame& F, int u0, int u1, const float* sink) {
    const int tid = F.tid, lane = F.lane, w = F.wave, r = lane & 31, h = lane >> 5;
    LAS unsigned char* lds = F.lds;
    const int qr = 32 * (w & 3) + r;
    const int krow = tid >> 3, kch = tid & 7, vrow = tid >> 4, vch = tid & 15;
    u32x4 kreg0, kreg1, vreg0, vreg1;
#define ATT_LOAD(U, t2) do { const int _p = ((t2) < (U).nloc2) ? 128 * ((U).jt0h + (t2)) : SEQ + 128 * ((t2) - (U).nloc2); \
        kreg0 = *(const u32x4*)((U).K + (size_t)(_p + krow) * HD + 8 * kch); kreg1 = *(const u32x4*)((U).K + (size_t)(_p + 64 + krow) * HD + 8 * kch); \
        vreg0 = *(const u32x4*)((U).Vt + (size_t)vrow * KPOS + _p + 8 * vch); vreg1 = *(const u32x4*)((U).Vt + (size_t)(32 + vrow) * KPOS + _p + 8 * vch); } while (0)
#define ATT_STORE(buf) do { LAS unsigned char* _b = lds + (buf) * KV_BUF; \
        *(LAS u32x4*)(_b + krow * KT_STRIDE + 16 * kch) = kreg0; *(LAS u32x4*)(_b + (64 + krow) * KT_STRIDE + 16 * kch) = kreg1; \
        LAS u32x2* _v0 = (LAS u32x2*)(_b + KT_BYTES + vrow * VT_STRIDE + 16 * vch); _v0[0] = (u32x2){vreg0.x, vreg0.y}; _v0[1] = (u32x2){vreg0.z, vreg0.w}; \
        LAS u32x2* _v1 = (LAS u32x2*)(_b + KT_BYTES + (32 + vrow) * VT_STRIDE + 16 * vch); _v1[0] = (u32x2){vreg1.x, vreg1.y}; _v1[1] = (u32x2){vreg1.z, vreg1.w}; } while (0)
#define ATT_LOADQ(U) do { const bf16_t* _qp = (U).Q + ((U).qrow0 + qr) * 256 + (2 * (U).kvh + (w >> 2)) * 64 + 8 * h; \
        _Pragma("unroll") for (int ks = 0; ks < 4; ++ks) qn[ks] = *(const bf16x8*)(_qp + 16 * ks); } while (0)
    int u = u0 + F.bid;
    __syncthreads();
    if (u < u1) {
        AUnit cur = attn_desc(F, u);
        bf16x8 qn[4];
        ATT_LOADQ(cur); ATT_LOAD(cur, 0); ATT_STORE(0);
        __syncthreads();
        int buf = 0;
        for (;;) {
            const int un = u + F.G; const bool has_next = un < u1;
            bf16x8 qf[4];
#pragma unroll
            for (int ks = 0; ks < 4; ++ks) qf[ks] = qn[ks];
            const int hq = 2 * cur.kvh + (w >> 2);
            f32x16 o0, o1, negm;
            float m = (!NOMAX && cur.use_sink) ? sink[hq] * LOG2E : 0.0f;
#pragma unroll
            for (int i = 0; i < 16; ++i) { o0[i] = 0.f; o1[i] = 0.f; negm[i] = -m; }
            float lsum = (!NOMAX && cur.use_sink && h == 0) ? 1.0f : 0.0f;
            for (int t2 = 0; t2 < cur.nt2; ++t2) {
                const bool last = t2 + 1 == cur.nt2;
                if (!last) ATT_LOAD(cur, t2 + 1);
                else if (has_next) { const AUnit nxt = attn_desc(F, un); ATT_LOAD(nxt, 0); ATT_LOADQ(nxt); }
                if (w >= 4) __builtin_amdgcn_s_sleep(ATT_STAGGER);
                LAS unsigned char* kb_ = lds + buf * KV_BUF; LAS unsigned char* vb_ = kb_ + KT_BYTES;
                attn_tile<NOMAX>(kb_, vb_, qf, o0, o1, negm, m, lsum, cur.masked && t2 < cur.nloc2, 128 * (cur.jt0h + t2), cur.qpos0, qr, r, h);
                if (!last || has_next) ATT_STORE(buf ^ 1);
                __syncthreads();
                buf ^= 1;
            }
            const float ltot = xor32_sum(lsum);
            const float inv = 1.0f / ltot;
            bf16_t* yp = F.Y() + (cur.qrow0 + qr) * D + cur.ycol + hq * 64 + 4 * h;
#pragma unroll
            for (int g = 0; g < 4; ++g) { u32x2 v0, v1;
                v0.x = pk_bf16(o0[4 * g] * inv, o0[4 * g + 1] * inv); v0.y = pk_bf16(o0[4 * g + 2] * inv, o0[4 * g + 3] * inv);
                v1.x = pk_bf16(o1[4 * g] * inv, o1[4 * g + 1] * inv); v1.y = pk_bf16(o1[4 * g + 2] * inv, o1[4 * g + 3] * inv);
                *(u32x2*)(yp + 8 * g) = v0; *(u32x2*)(yp + 32 + 8 * g) = v1; }
            if (!has_next) break;
            cur = attn_desc(F, un); u = un;
        }
    }
#undef ATT_LOAD
#undef ATT_STORE
#undef ATT_LOADQ
    __syncthreads();
}
DI void phase_attn(const Frame& F0, int l) {
    const Frame F = refresh(F0);
    const int nunits = (l == NL - 1) ? 2048 : 2304;
    const float* sink = F.P->in[I_SINK] + l * 4;
    float gq = fabsf(F.P->in[I_QNG][l * 64 + F.lane]), gk = fabsf(F.P->in[I_KNG][l * 64 + F.lane]);
    gq = wave_max(gq); gk = wave_max(gk);
    const float sbound = 8.0f * gq * gk * LOG2E * 1.02f;
    if (sbound < 40.0f) { attn_run<true>(F, 0, 1024, sink); attn_run<false>(F, 1024, nunits, sink); }
    else attn_run<false>(F, 0, nunits, sink);
}

constexpr int PH_PER_LAYER = 9, N_PHASES = 1 + NL * PH_PER_LAYER + 1;

__global__ void __launch_bounds__(NTHREADS, 2) mk_fwd(const Params args) {
    extern __shared__ __attribute__((aligned(16))) unsigned char lds_raw[];
    Frame F;
    F.lds = (LAS unsigned char*)lds_raw;
    F.tid = threadIdx.x; F.lane = F.tid & 63; F.wave = __builtin_amdgcn_readfirstlane(F.tid >> 6); F.G = gridDim.x; F.bid = blockIdx.x;
    F.P = (const __attribute__((address_space(4))) Params*)__builtin_amdgcn_kernarg_segment_ptr();

    volatile LAS unsigned* MISC = (volatile LAS unsigned*)(F.lds + MISC_OFF);
    if (F.tid < 64) MISC[F.tid] = 0u;
    __syncthreads();
    XcdBarrier bar; bar.bar = (unsigned*)(F.P->ws + WS_CTL); bar.x = 0; bar.st = nullptr;
    if (!MK_PER_PHASE) bar = xcd_barrier_post((unsigned*)(F.P->ws + WS_CTL), MISC + 8);

    const int lo = F.P->ph_lo, hi = F.P->ph_hi;
#define IN(k) (lo <= (k) && (k) < hi)
#define SEAM(k) do { if (IN((k) + 1)) xcd_barrier(bar); } while (0)

    if (PH_ON(0) && IN(0)) { for (int r = 0; r < REP(0); ++r) phase_prologue(F); SEAM(0); }

    for (int l = 0; l < NL; ++l) {
        const int p0 = 1 + l * PH_PER_LAYER;
        const bool lastl = (l == NL - 1);
        if (PH_ON(1) && IN(p0 + 0)) { for (int r = 0; r < REP(1); ++r) convert_weights(F, l); if (l == 0) { for (int r = 0; r < REP(11); ++r) phase_norm1<true>(F, 0); } else phase_norm1<false>(F, l); SEAM(p0 + 0); }
        if (PH_ON(2) && IN(p0 + 1)) {
            pg8::RectOrder S; S.init(NTOK / 256, INW / 256, F.G, F.bid); S.A = (const char*)F.H(); S.B = (const char*)F.WIN(); S.tstride = (size_t)256 * D;
            pg8::EpiPI8 E{F.R1(), INW, F.hs(), F.wmax() + l * INW};
            for (int r = 0; r < REP(2); ++r) pg8::gemm_phase<false, 2>(F.lds, S, E);
            SEAM(p0 + 1);
        }
        if (PH_ON(3) && IN(p0 + 2)) { for (int r = 0; r < REP(3); ++r) phase_prep(F, l); SEAM(p0 + 2); }
        if (PH_ON(4) && IN(p0 + 3)) { for (int r = 0; r < REP(4); ++r) phase_attn(F, l); SEAM(p0 + 3); }
        if (PH_ON(5) && IN(p0 + 4)) {
            pg8::RectOrder S; S.init((lastl ? NLAT : NTOK) / 256, D / 256, F.G, F.bid); S.A = (const char*)F.Y(); S.B = (const char*)F.WOUT(); S.tstride = (size_t)256 * D * 2;
            pg8::EpiDelta E{F.R1(), F.mods() + (size_t)l * 33 * 6144};
            for (int r = 0; r < REP(5); ++r) pg8::gemm_phase(F.lds, S, E);
            SEAM(p0 + 4);
        }
        if (PH_ON(6) && IN(p0 + 5)) { if (l == 0) phase_norm2_router<true>(F, l); else phase_norm2_router<false>(F, l); SEAM(p0 + 5); }
        if (PH_ON(7) && IN(p0 + 6)) { for (int r = 0; r < REP(7); ++r) phase_topk(F, l); SEAM(p0 + 6); }
        if (PH_ON(8) && IN(p0 + 7)) {
            pg8::MoeOrder S; S.init(lastl ? 512 : 576, 8, F.G, F.bid); S.A = (const char*)F.H(); S.B = (const char*)F.WGU(); S.estride = (size_t)2 * D * D; S.tstride = (size_t)256 * D; S.ridx = F.idx();
            pg8::EpiGU E{(unsigned char*)F.Gb()};
            for (int r = 0; r < REP(8); ++r) pg8::gemm_phase<true, 1>(F.lds, S, E);
            SEAM(p0 + 7);
        }
        if (PH_ON(9) && IN(p0 + 8)) {
            pg8::MoeOrder S; S.init(lastl ? 512 : 576, 4, F.G, F.bid); S.A = (const char*)F.Gb(); S.B = (const char*)F.WD(); S.estride = (size_t)D * D; S.tstride = (size_t)256 * D; S.ridx = nullptr;
            pg8::EpiDown E{(unsigned char*)F.R1(), F.gate()};
            for (int r = 0; r < REP(9); ++r) pg8::gemm_phase<false, 1>(F.lds, S, E);
            SEAM(p0 + 8);
        }
    }
    if (PH_ON(10) && IN(N_PHASES - 1)) phase_norm1<false>(F, NL);
#undef IN
#undef SEAM
}

extern "C" void kernel_launch(void* const* d_in, const int* in_sizes, int n_in, void* d_out, int out_size, void* d_ws, size_t ws_size, hipStream_t stream) {
    static int grid = 0;
    if (grid == 0) {
        if (n_in != 23 || out_size != NLAT * D || ws_size < WS_END) { fprintf(stderr, "kernel_launch: unexpected problem (n_in %d, out %d, ws %zu < %zu)\n", n_in, out_size, ws_size, (size_t)WS_END); grid = -1; return; }
        int dev = 0, cus = 0;
        if (hipGetDevice(&dev) != hipSuccess || hipDeviceGetAttribute(&cus, hipDeviceAttributeMultiprocessorCount, dev) != hipSuccess) { grid = -1; return; }
        if (hipFuncSetAttribute((const void*)mk_fwd, hipFuncAttributeMaxDynamicSharedMemorySize, LDS_BYTES) != hipSuccess) { fprintf(stderr, "kernel_launch: hipFuncSetAttribute failed\n"); grid = -1; return; }
        int per_cu = 0;
        if (hipOccupancyMaxActiveBlocksPerMultiprocessor(&per_cu, (const void*)mk_fwd, NTHREADS, LDS_BYTES) != hipSuccess || per_cu < 1) { fprintf(stderr, "kernel_launch: occupancy query says %d blocks per CU\n", per_cu); }
        (void)hipGetLastError();
        grid = cus;
    }
    if (grid < 0) return;
    (void)hipMemsetAsync((char*)d_ws + WS_CTL, 0, 65536, stream);
    Params p{};
    for (int i = 0; i < 23; ++i) p.in[i] = (const float*)d_in[i];
    p.out = (float*)d_out; p.ws = (unsigned char*)d_ws;
#if MK_PER_PHASE
    for (int ph = 0; ph < N_PHASES; ++ph) { p.ph_lo = ph; p.ph_hi = ph + 1; hipLaunchKernelGGL(mk_fwd, dim3(grid), dim3(NTHREADS), LDS_BYTES, stream, p); }
#else
    p.ph_lo = 0; p.ph_hi = N_PHASES;
    hipLaunchKernelGGL(mk_fwd, dim3(grid), dim3(NTHREADS), LDS_BYTES, stream, p);
#endif
}
```

```cpp
#include <hip/hip_runtime.h>
#include <cstdio>
#include <cstdint>

#ifndef MK_PER_PHASE
#define MK_PER_PHASE 0
#endif

#ifndef PH_MASK
#define PH_MASK 0x7ff
#endif
#define PH_ON(k) (((PH_MASK) >> (k)) & 1)
#ifndef REP_MASK
#define REP_MASK 0
#endif
#define REP(k) ((((REP_MASK) >> (k)) & 1) ? 2 : 1)
#define DI __device__ __forceinline__
#define LAS __attribute__((address_space(3)))
typedef unsigned short bf16_t;
typedef short bf16x8 __attribute__((ext_vector_type(8)));
typedef float f32x2 __attribute__((ext_vector_type(2)));
typedef float f32x4 __attribute__((ext_vector_type(4)));
typedef float f32x8 __attribute__((ext_vector_type(8)));
typedef float f32x16 __attribute__((ext_vector_type(16)));
typedef unsigned u32x2 __attribute__((ext_vector_type(2)));
typedef unsigned u32x4 __attribute__((ext_vector_type(4)));
typedef __bf16 bfv2 __attribute__((ext_vector_type(2)));
typedef __bf16 bfv8 __attribute__((ext_vector_type(8)));

constexpr int D = 1024, NB = 32, SEQ = 2048, NL = 4, CTX = 256, HD = 64, INW = 2304, NE = 16;
constexpr int NLAT = NB * SEQ, NCTX = NB * CTX, NTOK = NLAT + NCTX;
constexpr int KPOS = SEQ + CTX;
constexpr int CAP_L = 256, CAP_C = 32;
constexpr int NXS_L = NB * NE * CAP_L, NXS_C = NB * NE * CAP_C, NXS = NXS_L + NXS_C;
constexpr float EPS = 1e-6f;
constexpr float LOG2E = 1.4426950408889634f;

enum { I_X = 0, I_C, I_CTX, I_CCTX, I_ADAW, I_ADAB, I_N1, I_N2, I_WIN, I_CAW, I_CBW, I_CBB, I_CLNG, I_CLNB, I_SINK, I_QNG, I_KNG, I_WOUT, I_ROUTER, I_WGATE, I_WUP, I_WDOWN, I_FINALG };

constexpr size_t al256(size_t x) { return (x + 255) & ~(size_t)255; }
constexpr size_t WS_CTL   = 0;
constexpr size_t WS_MODS  = 65536;
constexpr size_t WS_ROPE  = al256(WS_MODS + (size_t)NL * 33 * 6144 * 4);
constexpr size_t WS_AFF   = al256(WS_ROPE + 64 * 16 * 2 * 4);
constexpr size_t WS_GATE  = al256(WS_AFF + (size_t)(NB * NE * SEQ + NB * NE * CTX) * 4);
constexpr size_t WS_HS    = al256(WS_GATE + (size_t)NXS * 4);
constexpr size_t WS_IDX   = al256(WS_HS + (size_t)NTOK * 4);
constexpr size_t WS_SEL   = al256(WS_IDX + (size_t)NXS * 4);
constexpr size_t WS_XC    = al256(WS_SEL + (size_t)(NLAT + NCTX) * 16 * 2);
constexpr size_t WS_H     = al256(WS_XC + (size_t)NTOK * D * 2);
constexpr size_t WS_R1    = al256(WS_H + (size_t)NTOK * D * 2);
constexpr size_t WS_R2    = al256(WS_R1 + (size_t)NTOK * INW * 2);
constexpr size_t R2_Y = 0, R2_QC = (size_t)NTOK * D * 2, R2_QD = R2_QC + (size_t)NTOK * 256 * 2, R2_KC = R2_QD + (size_t)NTOK * 256 * 2;
constexpr size_t KV_BYTES = (size_t)NB * 2 * KPOS * HD * 2;
constexpr size_t R2_KD = R2_KC + KV_BYTES, R2_VCT = R2_KD + KV_BYTES, R2_VDT = R2_VCT + KV_BYTES, R2_END = R2_VDT + KV_BYTES;
static_assert(R2_END == (size_t)NXS * D * 2, "G overlays Y|Q|K|V exactly");
constexpr size_t WS_WIN   = al256(WS_R2 + R2_END);
constexpr size_t WS_WOUT  = al256(WS_WIN + (size_t)INW * D * 2);
constexpr size_t WS_WGU   = al256(WS_WOUT + (size_t)D * D * 2);
constexpr size_t WS_WD    = al256(WS_WGU + (size_t)NE * 2 * D * D);
constexpr size_t WS_END   = al256(WS_WD + (size_t)NE * D * D);

constexpr int LDS_BYTES = 147456;
constexpr int MISC_OFF  = LDS_BYTES - 256;
constexpr int NTHREADS = 512;

struct Params { const float* in[23]; float* out; unsigned char* ws; int ph_lo, ph_hi; };

DI unsigned pk_bf16(float lo, float hi) { f32x2 v = {lo, hi}; return __builtin_bit_cast(unsigned, __builtin_convertvector(v, bfv2)); }
DI unsigned pk_fp8x4(float a, float b, float c, float d) {
    a = __builtin_amdgcn_fmed3f(a, -448.f, 448.f); b = __builtin_amdgcn_fmed3f(b, -448.f, 448.f); c = __builtin_amdgcn_fmed3f(c, -448.f, 448.f); d = __builtin_amdgcn_fmed3f(d, -448.f, 448.f);
    int w = 0; w = __builtin_amdgcn_cvt_pk_fp8_f32(a, b, w, false); w = __builtin_amdgcn_cvt_pk_fp8_f32(c, d, w, true); return (unsigned)w; }
DI unsigned pk_i8x4(float a, float b, float c, float d) {
    const int ia = (int)rintf(__builtin_amdgcn_fmed3f(a, -127.f, 127.f)), ib = (int)rintf(__builtin_amdgcn_fmed3f(b, -127.f, 127.f)), ic = (int)rintf(__builtin_amdgcn_fmed3f(c, -127.f, 127.f)), id = (int)rintf(__builtin_amdgcn_fmed3f(d, -127.f, 127.f));
    return (unsigned)(ia & 255) | ((unsigned)(ib & 255) << 8) | ((unsigned)(ic & 255) << 16) | ((unsigned)id << 24); }
DI float bf_lo(unsigned u) { return __uint_as_float(u << 16); }
DI float bf_hi(unsigned u) { return __uint_as_float(u & 0xffff0000u); }
template <int CTRL> DI float dpp_mov(float v) { return __builtin_bit_cast(float, __builtin_amdgcn_update_dpp(__builtin_bit_cast(int, v), __builtin_bit_cast(int, v), CTRL, 0xf, 0xf, false)); }
constexpr int DPP_X1 = 0xB1  , DPP_X2 = 0x4E  , DPP_HMIR = 0x141  , DPP_MIR = 0x140  ;
DI void swap16(float& a, float& b) { asm volatile("s_nop 1\n\tv_permlane16_swap_b32 %0, %1" : "+v"(a), "+v"(b)); }
DI void swap32(float& a, float& b) { asm volatile("s_nop 1\n\tv_permlane32_swap_b32 %0, %1" : "+v"(a), "+v"(b)); }
DI float xor32_sum(float v) { float a = v, b = v; swap32(a, b); return a + b; }
DI float xor32_max(float v) { float a = v, b = v; swap32(a, b); return fmaxf(a, b); }
DI float wave_sum(float v) {
    v += dpp_mov<DPP_X1>(v); v += dpp_mov<DPP_X2>(v); v += dpp_mov<DPP_HMIR>(v); v += dpp_mov<DPP_MIR>(v);
    { float a = v, b = v; swap16(a, b); v = a + b; }
    return xor32_sum(v);
}
DI float wave_max(float v) {
    v = fmaxf(v, dpp_mov<DPP_X1>(v)); v = fmaxf(v, dpp_mov<DPP_X2>(v)); v = fmaxf(v, dpp_mov<DPP_HMIR>(v)); v = fmaxf(v, dpp_mov<DPP_MIR>(v));
    { float a = v, b = v; swap16(a, b); v = fmaxf(a, b); }
    return xor32_max(v);
}
DI float fast_sigmoid(float x) { return __builtin_amdgcn_rcpf(1.0f + __builtin_amdgcn_exp2f(-x * LOG2E)); }

#define XB_TMO      128
#define XB_XCNT(j)  (256  + 64 * (j))
#define XB_XSUB(j)  (1280 + 64 * (j))
#define XB_XGEN(j)  (2304 + 64 * (j))
#define XB_TOP      3328
#define XB_TOPGEN   3392
#define XCD_BAR_WORDS 3456
#define XB_SPIN_CAP (1u << 24)

DI unsigned xb_ld(unsigned* p)              { return __hip_atomic_load(p, __ATOMIC_RELAXED, __HIP_MEMORY_SCOPE_AGENT); }
DI unsigned xb_add(unsigned* p, unsigned v) { return __hip_atomic_fetch_add(p, v, __ATOMIC_RELAXED, __HIP_MEMORY_SCOPE_AGENT); }
DI unsigned xb_xcc_id() { return (unsigned)__builtin_amdgcn_s_getreg((3 << 11) | 20) & 0xFu; }
#define XB_SPIN(cond, bar) do { unsigned _sp = 0; while (cond) { __builtin_amdgcn_s_sleep(1); \
    if ((++_sp & 255u) == 0u) { if (xb_ld(&(bar)[XB_TMO])) break; if (_sp > XB_SPIN_CAP) { atomicAdd(&(bar)[XB_TMO], 1u); break; } } } } while (0)

struct XcdBarrier { unsigned* bar; unsigned x; volatile LAS unsigned* st; };

DI XcdBarrier xcd_barrier_post(unsigned* bar, volatile LAS unsigned* st) {
    XcdBarrier b; b.bar = bar; b.x = xb_xcc_id(); b.st = st;
    if (threadIdx.x == 0) (void)xb_add(&bar[XB_XCNT(b.x)], 1u);
    return b;
}
DI void xcd_barrier_complete(unsigned* bar, unsigned x, unsigned& nloc, unsigned& nx) {
    const unsigned G = gridDim.x * gridDim.y * gridDim.z;
    unsigned sum, cnt, mine, sp = 0u;
    for (;;) {
        sum = 0u; cnt = 0u; mine = 0u;
#pragma unroll
        for (unsigned j = 0; j < 16; ++j) { const unsigned c = xb_ld(&bar[XB_XCNT(j)]); sum += c; cnt += (c > 0u) ? 1u : 0u; mine = (j == x) ? c : mine; }
        if (sum == G) break;
        __builtin_amdgcn_s_sleep(1);
        if ((++sp & 255u) == 0u) { if (xb_ld(&bar[XB_TMO])) break; if (sp > XB_SPIN_CAP) { atomicAdd(&bar[XB_TMO], 1u); break; } }
    }
    nloc = mine > 0u ? mine : 1u; nx = cnt > 0u ? cnt : 1u;
}
DI void xcd_barrier(const XcdBarrier& b) {
    asm volatile("s_waitcnt vmcnt(0)" ::: "memory");
    __syncthreads();
    if (threadIdx.x == 0) {
        unsigned* bar = b.bar;
        __builtin_amdgcn_s_waitcnt(0);
        unsigned nloc = b.st[0], nx = b.st[1];
        if (nloc == 0u) { xcd_barrier_complete(bar, b.x, nloc, nx); b.st[0] = nloc; b.st[1] = nx; }
        const unsigned old = xb_add(&bar[XB_XSUB(b.x)], 1u);
        const unsigned gen = old / nloc;
        if (old + 1u == (gen + 1u) * nloc) {
            __builtin_amdgcn_fence(__ATOMIC_RELEASE, "agent");
            asm volatile("s_waitcnt vmcnt(0)" ::: "memory");
            const unsigned og = xb_add(&bar[XB_TOP], 1u);
            const unsigned tg = og / nx;
            if (og + 1u == (tg + 1u) * nx) xb_add(&bar[XB_TOPGEN], 1u);
            else XB_SPIN(xb_ld(&bar[XB_TOPGEN]) == tg, bar);
            __builtin_amdgcn_fence(__ATOMIC_ACQUIRE, "agent");
            xb_add(&bar[XB_XGEN(b.x)], 1u);
            asm volatile("s_waitcnt vmcnt(0)" ::: "memory");
        } else {
            XB_SPIN(xb_ld(&bar[XB_XGEN(b.x)]) == gen, bar);
            __builtin_amdgcn_fence(__ATOMIC_ACQUIRE, "agent");
            asm volatile("s_waitcnt vmcnt(0)" ::: "memory");
        }
    }
    __syncthreads();
}

namespace pg8 {
constexpr int BM = 256, BK = 64, HALF = 128, HTB = HALF * BK * 2, STAGE_BYTES = 8 * HTB, NXCD = 8, WGM = 8, GK = 1024;
DI int lds_byte(int r, int c) { const int st = (r >> 4) * 2 + (c >> 5), rr = r & 15, cc = c & 31, ob = rr * 64 + cc * 2; return st * 1024 + (ob ^ (((ob >> 9) & 1) << 5)); }
DI void stage_rc(int b, int& R, int& C) { const int st = b / 1024, sb = b % 1024, swz = sb ^ (((sb >> 9) & 1) << 5); R = (st >> 1) * 16 + swz / 64; C = (st & 1) * 32 + (swz % 64) / 2; }
DI int perm32(int rho) { const int n = rho >> 4, i = rho & 15; return 8 * (i >> 2) + 4 * n + (i & 3); }

struct GUnit { const char* a; const char* b; const int* ridx; int pm, pn; };

struct OrderBase {
    int nM, nN, nwg, G, c;
    DI void init(int nM_, int nN_, int G_, int c_) { nM = nM_; nN = nN_; nwg = nM * nN; G = G_; c = c_; }
    DI bool map(int i, int& pm, int& pn) const {
        const long L = (long)i * G + c; if (L >= nwg) return false;
        int wgid = (int)L; { const int q = nwg / NXCD, r = nwg % NXCD, xcd = wgid % NXCD, off = wgid / NXCD; wgid = (xcd < r ? xcd * (q + 1) : r * (q + 1) + (xcd - r) * q) + off; }
        const int nig = WGM * nN, gid = wgid / nig, fm = gid * WGM, gsz = (nM - fm) < WGM ? (nM - fm) : WGM;
        pm = fm + ((wgid % nig) % gsz); pn = (wgid % nig) / gsz; return true;
    }
};
struct RectOrder : OrderBase {
    const char* A; const char* B; size_t tstride;
    DI bool next(int i, GUnit& u) const { int pm, pn; if (!map(i, pm, pn)) return false; u.pm = pm; u.pn = pn; u.a = A + (size_t)pm * tstride; u.ridx = nullptr; u.b = B + (size_t)pn * tstride; return true; }
};
struct MoeOrder : OrderBase {
    const char* A; const char* B; size_t estride; size_t tstride; const int* ridx;
    DI bool next(int i, GUnit& u) const { int pm, pn; if (!map(i, pm, pn)) return false; u.pm = pm; u.pn = pn; const int e = pm < 512 ? (pm >> 5) : ((pm - 512) >> 2);
        u.a = ridx ? A : A + (size_t)pm * tstride; u.ridx = ridx ? ridx + pm * BM : nullptr; u.b = B + (size_t)e * estride + (size_t)pn * tstride; return true; }
};

typedef f32x4 Acc[2][2][4][2];
constexpr int EV_OFF = 8 * 16384, EV_BYTES = 2048;
constexpr float W8_SCALE = 64.0f, W8_INV = 1.0f / 64.0f;

struct EpiBf16Plain {
    static constexpr bool PERM = true;
    bf16_t* O; int ldc;
    DI const char* ev_row(const GUnit&) const { return nullptr; }
    DI const char* ev_col(const GUnit&) const { return nullptr; }
    DI void operator()(const Acc& acc, const GUnit& u, int wr, int wc, int fr, int fq, const LAS float*) const {
        const int row0 = u.pm * BM + wr * 64 + fr, col0 = u.pn * BM + wc * 32 + 8 * fq;
#pragma unroll
        for (int ai = 0; ai < 2; ++ai)
#pragma unroll
            for (int m = 0; m < 4; ++m) { bf16_t* rowp = O + (size_t)(row0 + ai * HALF + m * 16) * ldc + col0;
#pragma unroll
                for (int bj = 0; bj < 2; ++bj) { const f32x4 v0 = acc[ai][bj][m][0], v1 = acc[ai][bj][m][1];
                    u32x4 w; w.x = pk_bf16(v0[0], v0[1]); w.y = pk_bf16(v0[2], v0[3]); w.z = pk_bf16(v1[0], v1[1]); w.w = pk_bf16(v1[2], v1[3]);
                    *(u32x4*)(rowp + bj * HALF) = w; } }
    }
};
constexpr float YD_SCALE = 16.0f, YD_INV = 1.0f / 16.0f;
struct EpiPI8 {
    static constexpr bool PERM = true;
    bf16_t* O; int ldc; const float* rowscale; const unsigned* colmax;
    DI const char* ev_row(const GUnit& u) const { return (const char*)(rowscale + u.pm * BM); }
    DI const char* ev_col(const GUnit& u) const { return (const char*)(colmax + u.pn * BM); }
    DI void operator()(const Acc& acc, const GUnit& u, int wr, int wc, int fr, int fq, const LAS float* ev) const {
        const int rl0 = wr * 64 + fr, cl0 = wc * 32 + 8 * fq;
        const int row0 = u.pm * BM + rl0, col0 = u.pn * BM + cl0;
        f32x4 cs[2][2];
#pragma unroll
        for (int bj = 0; bj < 2; ++bj)
#pragma unroll
            for (int n = 0; n < 2; ++n) cs[bj][n] = *(const LAS f32x4*)(ev + 256 + cl0 + bj * HALF + 4 * n) * (1.0f / 127.0f);
#pragma unroll
        for (int ai = 0; ai < 2; ++ai)
#pragma unroll
            for (int m = 0; m < 4; ++m) { const int row = row0 + ai * HALF + m * 16; const float g = ev[rl0 + ai * HALF + m * 16]; bf16_t* rowp = O + (size_t)row * ldc + col0;
#pragma unroll
                for (int bj = 0; bj < 2; ++bj) { const f32x4 v0 = acc[ai][bj][m][0] * g * cs[bj][0], v1 = acc[ai][bj][m][1] * g * cs[bj][1];
                    u32x4 w; w.x = pk_bf16(v0[0], v0[1]); w.y = pk_bf16(v0[2], v0[3]); w.z = pk_bf16(v1[0], v1[1]); w.w = pk_bf16(v1[2], v1[3]);
                    *(u32x4*)(rowp + bj * HALF) = w; } }
    }
};
DI void swap16u(unsigned& a, unsigned& b) { asm volatile("s_nop 1\n\tv_permlane16_swap_b32 %0, %1" : "+v"(a), "+v"(b)); }
struct EpiDown {
    static constexpr bool PERM = true;
    unsigned char* O; const float* gate;
    DI const char* ev_row(const GUnit& u) const { return (const char*)(gate + u.pm * BM); }
    DI const char* ev_col(const GUnit&) const { return nullptr; }
    DI void operator()(const Acc& acc, const GUnit& u, int wr, int wc, int fr, int fq, const LAS float* ev) const {
        const int rl0 = wr * 64 + fr;
        const int row0 = u.pm * BM + rl0, colw = u.pn * BM + wc * 32 + 16 * (fq >> 1);
#pragma unroll
        for (int ai = 0; ai < 2; ++ai)
#pragma unroll
            for (int mp = 0; mp < 2; ++mp) { const int m0 = 2 * mp;
                const float g0 = ev[rl0 + ai * HALF + m0 * 16] * (YD_SCALE / 64.0f), g1 = ev[rl0 + ai * HALF + (m0 + 1) * 16] * (YD_SCALE / 64.0f);
                unsigned char* rowp = O + (size_t)(row0 + ai * HALF + (m0 + (fq & 1)) * 16) * D + colw;
#pragma unroll
                for (int bj = 0; bj < 2; ++bj) { const f32x4 a0 = acc[ai][bj][m0][0] * g0, a1 = acc[ai][bj][m0][1] * g0, b0 = acc[ai][bj][m0 + 1][0] * g1, b1 = acc[ai][bj][m0 + 1][1] * g1;
                    unsigned ax = pk_fp8x4(a0[0], a0[1], a0[2], a0[3]), ay = pk_fp8x4(a1[0], a1[1], a1[2], a1[3]), bx = pk_fp8x4(b0[0], b0[1], b0[2], b0[3]), by = pk_fp8x4(b1[0], b1[1], b1[2], b1[3]);
                    swap16u(ax, bx); swap16u(ay, by);
                    *(u32x4*)(rowp + bj * HALF) = (u32x4){ax, ay, bx, by}; } }
    }
};
struct EpiGU {
    static constexpr bool PERM = true;
    unsigned char* O;
    DI const char* ev_row(const GUnit&) const { return nullptr; }
    DI const char* ev_col(const GUnit&) const { return nullptr; }
    DI void operator()(const Acc& acc, const GUnit& u, int wr, int wc, int fr, int fq, const LAS float*) const {
        const int row0 = u.pm * BM + wr * 64 + fr, colw = u.pn * 128 + wc * 32 + 16 * (fq >> 1);
#pragma unroll
        for (int ai = 0; ai < 2; ++ai)
#pragma unroll
          for (int mp = 0; mp < 2; ++mp) { unsigned wx[2], wy[2];
#pragma unroll
            for (int mm = 0; mm < 2; ++mm) { const int m = 2 * mp + mm; float g[8];
#pragma unroll
                for (int n = 0; n < 2; ++n)
#pragma unroll
                    for (int j = 0; j < 4; ++j) { const float aa = acc[ai][0][m][n][j], uu = acc[ai][1][m][n][j];
                        const float e = __builtin_amdgcn_exp2f(aa * (-LOG2E * W8_INV));
                        g[4 * n + j] = (aa * uu) * __builtin_amdgcn_rcpf(__builtin_fmaf(e, W8_SCALE * W8_SCALE, W8_SCALE * W8_SCALE)); }
                wx[mm] = pk_fp8x4(g[0], g[1], g[2], g[3]); wy[mm] = pk_fp8x4(g[4], g[5], g[6], g[7]); }
            swap16u(wx[0], wx[1]); swap16u(wy[0], wy[1]);
            *(u32x4*)(O + (size_t)(row0 + ai * HALF + (2 * mp + (fq & 1)) * 16) * D + colw) = (u32x4){wx[0], wy[0], wx[1], wy[1]}; }
    }
};
struct EpiDelta {
    static constexpr bool PERM = true;
    bf16_t* O; const float* mods_l;
    DI const char* ev_row(const GUnit&) const { return nullptr; }
    DI const char* ev_col(const GUnit& u) const { return (const char*)(mods_l + (size_t)(u.pm >= 256 ? 32 : (u.pm >> 3)) * 6144 + 2048 + u.pn * BM); }
    DI void operator()(const Acc& acc, const GUnit& u, int wr, int wc, int fr, int fq, const LAS float* ev) const {
        const int cl0 = wc * 32 + 8 * fq;
        const int row0 = u.pm * BM + wr * 64 + fr, col0 = u.pn * BM + cl0;
        f32x4 gv[2][2];
#pragma unroll
        for (int bj = 0; bj < 2; ++bj)
#pragma unroll
            for (int n = 0; n < 2; ++n) gv[bj][n] = *(const LAS f32x4*)(ev + 256 + cl0 + bj * HALF + 4 * n);
#pragma unroll
        for (int ai = 0; ai < 2; ++ai)
#pragma unroll
            for (int m = 0; m < 4; ++m) { bf16_t* rowp = O + (size_t)(row0 + ai * HALF + m * 16) * D + col0;
#pragma unroll
                for (int bj = 0; bj < 2; ++bj) { const f32x4 v0 = acc[ai][bj][m][0] * gv[bj][0], v1 = acc[ai][bj][m][1] * gv[bj][1];
                    u32x4 w; w.x = pk_bf16(v0[0], v0[1]); w.y = pk_bf16(v0[2], v0[3]); w.z = pk_bf16(v1[0], v1[1]); w.w = pk_bf16(v1[2], v1[3]);
                    *(u32x4*)(rowp + bj * HALF) = w; } }
    }
};

typedef int i32x8 __attribute__((ext_vector_type(8)));
typedef short s16x16a __attribute__((ext_vector_type(16), aligned(16)));
typedef int i32x4 __attribute__((ext_vector_type(4)));
DI i32x8 frag8(bf16x8 lo, bf16x8 hi) { const i32x4 a = __builtin_bit_cast(i32x4, lo), b = __builtin_bit_cast(i32x4, hi); return (i32x8){a[0], a[1], a[2], a[3], b[0], b[1], b[2], b[3]}; }

DI void mfma_f8_acc(f32x4& acc, const i32x8& a, const i32x8& b) { asm volatile("s_nop 1\n\tv_mfma_f32_16x16x128_f8f6f4 %0, %1, %2, %0" : "+v"(acc) : "v"(a), "v"(b)); }

DI void mfma_zero(f32x4& acc, const u32x2& zz) { asm volatile("s_nop 1\n\tv_mfma_f32_4x4x4_16b_f16 %0, %1, %1, 0" : "=&v"(acc) : "v"(zz)); }
DI void mfma_f8_zero(f32x4& acc, const i32x8& a, const i32x8& b) { asm volatile("s_nop 1\n\tv_mfma_f32_16x16x128_f8f6f4 %0, %1, %2, 0" : "+v"(acc) : "v"(a), "v"(b)); }
DI void mfma_i8_zero(f32x4& acc, const bf16x8& a, const bf16x8& b) { asm volatile("s_nop 1\n\tv_mfma_i32_16x16x64_i8 %0, %1, %2, 0" : "+v"(acc) : "v"(a), "v"(b)); }
DI void mfma_bf16_zero(f32x4& acc, const bf16x8& a, const bf16x8& b) { asm volatile("s_nop 1\n\tv_mfma_f32_16x16x32_bf16 %0, %1, %2, 0" : "+v"(acc) : "v"(a), "v"(b)); }
DI void mfma_i8_acc(f32x4& acc, const bf16x8& a, const bf16x8& b) { asm volatile("s_nop 1\n\tv_mfma_i32_16x16x64_i8 %0, %1, %2, %0" : "+v"(acc) : "v"(a), "v"(b)); }

template <bool GATHER = false, int MODE = 0  , class Epi, class Sched>
DI void gemm_phase(LAS unsigned char* lds, const Sched& S, const Epi& E) {
    int tid = threadIdx.x; asm volatile("" : "+v"(tid));
    const int wid = __builtin_amdgcn_readfirstlane(tid >> 6), lane = tid & 63, wr = wid >> 2, wc = wid & 3, fr = lane & 15, fq = lane >> 4;
    constexpr int ES = MODE == 0 ? 2 : 1  ; constexpr bool F16B = MODE != 1  ;
    constexpr int K = GK, RB = K * ES  , nt = RB / (BK * 2)  ;
    unsigned voffA[2], voffB[2]; int gR[2]; unsigned gC[2];
#pragma unroll
    for (int i = 0; i < 2; ++i) { int R, C; stage_rc(tid * 16 + i * 8192, R, C); const int Rb = Epi::PERM ? ((R & ~31) + perm32(R & 31)) : R;
        voffA[i] = (unsigned)(R * RB + C * 2); voffB[i] = (unsigned)(Rb * RB + C * 2); gR[i] = R; gC[i] = (unsigned)C * 2u; }
    unsigned vgc0[2], vgc1[2], vgn0[2], vgn1[2]; int raw0[2], raw1[2];
    constexpr size_t kstep = (size_t)(BK * 2);
    constexpr size_t hstep = (size_t)HALF * RB;
    const unsigned ldsw = (unsigned)wid * 1024u;
    const int aoff = F16B ? lds_byte(wr * 64 + fr, fq * 8) : lds_byte(wr * 64 + fr, fq * 16), boff = F16B ? lds_byte(wc * 32 + fr, fq * 8) : lds_byte(wc * 32 + fr, fq * 16);
#define PG8_SA(b, h) (((b) * 2 + (h)) * HTB)
#define PG8_SB(b, h) ((4 + (b) * 2 + (h)) * HTB)
#define PG8_STAGE(bufoff, gbase, voff) do { _Pragma("unroll") for (int _i = 0; _i < 2; ++_i) \
        __builtin_amdgcn_global_load_lds((const unsigned*)((const char*)(gbase) + (voff)[_i]), (LAS unsigned*)(lds + (bufoff) + ldsw + _i * 8192), 16, 0, 0); } while (0)
#define PG8_LDA(dst, b, h) do { if (F16B) { _Pragma("unroll") for (int m = 0; m < 4; ++m) _Pragma("unroll") for (int k = 0; k < 2; ++k) dst[m][k] = *(const LAS bf16x8*)(lds + PG8_SA(b, h) + aoff + m * 2048 + k * 1024); } \
        else { _Pragma("unroll") for (int m = 0; m < 4; ++m) dst##8[m] = frag8(*(const LAS bf16x8*)(lds + PG8_SA(b, h) + aoff + m * 2048), *(const LAS bf16x8*)(lds + PG8_SA(b, h) + aoff + m * 2048 + 16)); } } while (0)
#define PG8_LDB(dst, b, h) do { if (F16B) { _Pragma("unroll") for (int n = 0; n < 2; ++n) _Pragma("unroll") for (int k = 0; k < 2; ++k) dst[n][k] = *(const LAS bf16x8*)(lds + PG8_SB(b, h) + boff + n * 2048 + k * 1024); } \
        else { _Pragma("unroll") for (int n = 0; n < 2; ++n) dst##8[n] = frag8(*(const LAS bf16x8*)(lds + PG8_SB(b, h) + boff + n * 2048), *(const LAS bf16x8*)(lds + PG8_SB(b, h) + boff + n * 2048 + 16)); } } while (0)
#define PG8_MMA_(ai, bj, At, Bt, Z) do { __builtin_amdgcn_s_setprio(1); _Pragma("unroll") for (int m = 0; m < 4; ++m) _Pragma("unroll") for (int n = 0; n < 2; ++n) { \
        if (MODE == 0) { _Pragma("unroll") for (int k = 0; k < 2; ++k) { if ((Z) && k == 0) mfma_bf16_zero(acc[ai][bj][m][n], Bt[n][k], At[m][k]); else acc[ai][bj][m][n] = __builtin_amdgcn_mfma_f32_16x16x32_bf16(Bt[n][k], At[m][k], acc[ai][bj][m][n], 0, 0, 0); } } \
        else if (MODE == 2) { _Pragma("unroll") for (int k = 0; k < 2; ++k) { if ((Z) && k == 0) mfma_i8_zero(acc[ai][bj][m][n], Bt[n][k], At[m][k]); else mfma_i8_acc(acc[ai][bj][m][n], Bt[n][k], At[m][k]); } } \
        else { if (Z) mfma_f8_zero(acc[ai][bj][m][n], Bt##8[n], At##8[m]); else mfma_f8_acc(acc[ai][bj][m][n], Bt##8[n], At##8[m]); } } \
        __builtin_amdgcn_s_setprio(0); } while (0)
#define PG8_MMA(ai, bj, At, Bt) PG8_MMA_(ai, bj, At, Bt, false)
#define PG8_MMAZ(ai, bj, At, Bt) PG8_MMA_(ai, bj, At, Bt, true)
#define PG8_WAIT_V(n) asm volatile("s_waitcnt vmcnt(" #n ")" ::: "memory")
#define PG8_WAIT_L(n) asm volatile("s_waitcnt lgkmcnt(" #n ")" ::: "memory")
#define PG8_BAR __builtin_amdgcn_s_barrier()
#define PG8_SCHED __builtin_amdgcn_sched_barrier(0)
    GUnit cur, nxt; int ui = 0;
    if (!S.next(0, cur)) return;
#if GEMM_STAGGER
    for (int d = 0; d < (int)((blockIdx.x >> 3) & 3); ++d) __builtin_amdgcn_s_sleep(GEMM_STAGGER);
#endif
    Acc acc;
#pragma unroll
    for (int a = 0; a < 2; ++a)
#pragma unroll
        for (int b = 0; b < 2; ++b)
#pragma unroll
            for (int m = 0; m < 4; ++m)
#pragma unroll
                for (int n = 0; n < 2; ++n) acc[a][b][m][n] = (f32x4){0.f, 0.f, 0.f, 0.f};
    bf16x8 At[4][2], B0[2][2], B1[2][2];
    i32x8 At8[4], B08[2], B18[2];
    const char* cA = cur.a; const char* cB = cur.b;
    if (GATHER) {
#pragma unroll
        for (int i = 0; i < 2; ++i) { vgc0[i] = (unsigned)cur.ridx[gR[i]] * (unsigned)RB + gC[i]; vgc1[i] = (unsigned)cur.ridx[HALF + gR[i]] * (unsigned)RB + gC[i]; vgn0[i] = vgc0[i]; vgn1[i] = vgc1[i]; raw0[i] = 0; raw1[i] = 0; }
    }
#define PG8_STAGE_A(bufoff, p, h, g0, g1) do { if (GATHER) { if ((h) == 0) PG8_STAGE(bufoff, p, g0); else PG8_STAGE(bufoff, p, g1); } else PG8_STAGE(bufoff, (p) + (h) * hstep, voffA); } while (0)
    PG8_STAGE(PG8_SB(0, 0), cB, voffB); PG8_STAGE(PG8_SB(0, 1), cB + hstep, voffB); PG8_STAGE_A(PG8_SA(0, 0), cA, 0, vgc0, vgc1); PG8_STAGE_A(PG8_SA(0, 1), cA, 1, vgc0, vgc1);
    if (wr == 1) PG8_BAR;
    PG8_WAIT_V(2); PG8_BAR;
    PG8_STAGE(PG8_SB(1, 0), cB + kstep, voffB); PG8_STAGE_A(PG8_SA(1, 0), cA + kstep, 0, vgc0, vgc1); PG8_STAGE(PG8_SB(1, 1), cB + hstep + kstep, voffB);
    PG8_WAIT_V(6); PG8_BAR;
    for (;;) {
        const bool has_next = S.next(ui + 1, nxt);
        const char* nA = has_next ? nxt.a : cA; const char* nB = has_next ? nxt.b : cB;
        if (GATHER && has_next) {
#pragma unroll
            for (int i = 0; i < 2; ++i) { const int* p0 = nxt.ridx + gR[i]; const int* p1 = nxt.ridx + HALF + gR[i];
                asm volatile("global_load_dword %0, %1, off" : "=v"(raw0[i]) : "v"(p0) : "memory"); asm volatile("global_load_dword %0, %1, off" : "=v"(raw1[i]) : "v"(p1) : "memory"); }
        }
#define PG8_TRIP(MMAK0) do { \
            const bool last = (t == nt - 2); \
            if (t == 0) { \
                const char* er = E.ev_row(cur); const char* ec = E.ev_col(cur); \
                if (er != nullptr && wid == 0) __builtin_amdgcn_global_load_lds((const unsigned*)(er + (tid & 63) * 16), (LAS unsigned*)(lds + EV_OFF + (ui & 1) * EV_BYTES), 16, 0, 0); \
                if (ec != nullptr && wid == 1) __builtin_amdgcn_global_load_lds((const unsigned*)(ec + (tid & 63) * 16), (LAS unsigned*)(lds + EV_OFF + (ui & 1) * EV_BYTES + 1024), 16, 0, 0); \
            } \
            const char* a1 = cA + (size_t)(t + 1) * kstep; \
            const char* a2 = last ? nA : cA + (size_t)(t + 2) * kstep; const char* b2 = last ? nB : cB + (size_t)(t + 2) * kstep; \
            const char* a3 = a2 + kstep; const char* b3 = b2 + kstep; \
            if (GATHER && last && has_next) { \
            _Pragma("unroll") \
                for (int i = 0; i < 2; ++i) { asm volatile("" : "+v"(raw0[i])); asm volatile("" : "+v"(raw1[i])); vgn0[i] = (unsigned)raw0[i] * (unsigned)RB + gC[i]; vgn1[i] = (unsigned)raw1[i] * (unsigned)RB + gC[i]; } \
            } \
            unsigned vx0[2], vx1[2]; \
            _Pragma("unroll") \
            for (int i = 0; i < 2; ++i) { vx0[i] = last ? vgn0[i] : vgc0[i]; vx1[i] = last ? vgn1[i] : vgc1[i]; } \
            PG8_LDB(B0, 0, 0); PG8_LDB(B1, 0, 1); PG8_SCHED; PG8_LDA(At, 0, 0); PG8_STAGE_A(PG8_SA(1, 1), a1, 1, vgc0, vgc1); \
            PG8_WAIT_V(8); PG8_WAIT_L(0); PG8_BAR; MMAK0(0, 0, At, B0); MMAK0(0, 1, At, B1); PG8_BAR; PG8_SCHED; \
            PG8_LDA(At, 0, 1); PG8_STAGE(PG8_SB(0, 0), b2, voffB); PG8_STAGE(PG8_SB(0, 1), b2 + hstep, voffB); PG8_STAGE_A(PG8_SA(0, 0), a2, 0, vx0, vx1); \
            PG8_WAIT_V(8); PG8_WAIT_L(0); PG8_BAR; MMAK0(1, 0, At, B0); MMAK0(1, 1, At, B1); PG8_BAR; PG8_SCHED; \
            PG8_LDB(B0, 1, 0); PG8_LDB(B1, 1, 1); PG8_SCHED; PG8_LDA(At, 1, 0); PG8_STAGE_A(PG8_SA(0, 1), a2, 1, vx0, vx1); \
            PG8_WAIT_V(8); PG8_WAIT_L(0); PG8_BAR; PG8_MMA(0, 0, At, B0); PG8_MMA(0, 1, At, B1); PG8_BAR; PG8_SCHED; \
            PG8_LDA(At, 1, 1); PG8_STAGE(PG8_SB(1, 0), b3, voffB); PG8_STAGE(PG8_SB(1, 1), b3 + hstep, voffB); PG8_STAGE_A(PG8_SA(1, 0), a3, 0, vx0, vx1); \
            PG8_WAIT_V(8); PG8_WAIT_L(0); PG8_BAR; PG8_MMA(1, 0, At, B0); PG8_MMA(1, 1, At, B1); PG8_BAR; PG8_SCHED; \
        } while (0)
        { const int t = 0; PG8_TRIP(PG8_MMAZ); }
#pragma unroll 1
        for (int t = 2; t < nt; t += 2) PG8_TRIP(PG8_MMA);
#undef PG8_TRIP
        if (wr == 0) PG8_BAR;
        if (MODE != 0) asm volatile("s_nop 15\n\ts_nop 15" ::: "memory");
        if (MODE == 2) {
#pragma unroll
            for (int a = 0; a < 2; ++a)
#pragma unroll
                for (int b = 0; b < 2; ++b)
#pragma unroll
                    for (int m = 0; m < 4; ++m)
#pragma unroll
                        for (int n = 0; n < 2; ++n)
#pragma unroll
                            for (int j = 0; j < 4; ++j) acc[a][b][m][n][j] = (float)__float_as_int(acc[a][b][m][n][j]);
        }
        E(acc, cur, wr, wc, fr, fq, (const LAS float*)(lds + EV_OFF + (ui & 1) * EV_BYTES));
        if (!has_next) break;
        if (GATHER) {
#pragma unroll
            for (int i = 0; i < 2; ++i) { vgc0[i] = vgn0[i]; vgc1[i] = vgn1[i]; }
        }
        cur = nxt; cA = nA; cB = nB; ++ui;
        if (wr == 1) PG8_BAR;
    }
    PG8_WAIT_V(0);
    PG8_BAR;
#undef PG8_SA
#undef PG8_SB
#undef PG8_STAGE
#undef PG8_STAGE_A
#undef PG8_LDA
#undef PG8_LDB
#undef PG8_MMA
#undef PG8_MMAZ
#undef PG8_MMA_
#undef PG8_WAIT_V
#undef PG8_WAIT_L
#undef PG8_BAR
#undef PG8_SCHED
}
}

struct Frame {
    LAS unsigned char* lds; int tid, lane, wave, G, bid;
    const __attribute__((address_space(4))) Params* P;
#define WSP(T, off) ((T*)(P->ws + (off)))
    DI float* out() const { return P->out; }
    DI float* mods() const { return WSP(float, WS_MODS); }
    DI float* rope() const { return WSP(float, WS_ROPE); }
    DI float* aff() const { return WSP(float, WS_AFF); }
    DI float* gate() const { return WSP(float, WS_GATE); }
    DI short* sel() const { return WSP(short, WS_SEL); }
    DI int* idx() const { return WSP(int, WS_IDX); }
    DI float* hs() const { return WSP(float, WS_HS); }
    DI unsigned* wmax() const { return WSP(unsigned, WS_CTL + 20480); }
    DI bf16_t* xb() const { return WSP(bf16_t, WS_XC); }
    DI bf16_t* H() const { return WSP(bf16_t, WS_H); }
    DI bf16_t* R1() const { return WSP(bf16_t, WS_R1); }
    DI bf16_t* Y() const { return WSP(bf16_t, WS_R2 + R2_Y); }
    DI bf16_t* QC() const { return WSP(bf16_t, WS_R2 + R2_QC); }
    DI bf16_t* QD() const { return WSP(bf16_t, WS_R2 + R2_QD); }
    DI bf16_t* KC() const { return WSP(bf16_t, WS_R2 + R2_KC); }
    DI bf16_t* KD() const { return WSP(bf16_t, WS_R2 + R2_KD); }
    DI bf16_t* VCT() const { return WSP(bf16_t, WS_R2 + R2_VCT); }
    DI bf16_t* VDT() const { return WSP(bf16_t, WS_R2 + R2_VDT); }
    DI bf16_t* Gb() const { return WSP(bf16_t, WS_R2); }
    DI bf16_t* WIN() const { return WSP(bf16_t, WS_WIN); }
    DI bf16_t* WOUT() const { return WSP(bf16_t, WS_WOUT); }
    DI bf16_t* WGU() const { return WSP(bf16_t, WS_WGU); }
    DI bf16_t* WD() const { return WSP(bf16_t, WS_WD); }
};

DI Frame refresh(const Frame& F0) {
    Frame F; int t = threadIdx.x; asm volatile("" : "+v"(t)); F.tid = t; F.lane = t & 63; F.wave = __builtin_amdgcn_readfirstlane(t >> 6);
    const __attribute__((address_space(4))) Params* p = F0.P; asm volatile("" : "+s"(p)); F.P = p; F.lds = F0.lds; F.G = gridDim.x; F.bid = blockIdx.x; return F;
}

__device__ const double ROPE_CS[16][2] = {
  {0.54030230586813977, 0.8414709848078965},
  {0.84600910641876459, 0.53316844604357783},
  {0.95041528091621519, 0.31098359088696603},
  {0.98423023475537852, 0.17689218465882672},
  {0.99500416512926237, 0.099833418129499904},
  {0.99841927779381845, 0.056204499194192764},
  {0.99950004171911222, 0.031617504700607077},
  {0.99984189027985781, 0.017781857090886144},
  {0.99995000041890036, 0.0099998331106604232},
  {0.99998418865337735, 0.0056233836119069999},
  {0.99999500000426333, 0.0031622723591389961},
  {0.99999841886154905, 0.0017782784939288374},
  {0.99999949999999416, 0.00099999988083076933},
  {0.99999984188613433, 0.00056234127206397698},
  {0.99999995000000319, 0.00031622775186866914},
  {0.99999998418861191, 0.00017782793926880789},
};

DI void phase_prologue(const Frame& F0) {
    const Frame F = refresh(F0);
    const int tid = F.tid, w = F.wave, lane = F.lane;
    { LAS f32x4* red = (LAS f32x4*)F.lds;
      for (int u = F.G - 1 - F.bid; u < NL * 36; u += F.G) { const int l = u / 36, cb = u % 36, cq = tid & 15, rg = tid >> 4;
        const f32x4* wp = (const f32x4*)(F.P->in[I_WIN] + (size_t)l * D * INW + cb * 64 + 4 * cq);
        f32x4 mx = (f32x4){0.f, 0.f, 0.f, 0.f};
#pragma unroll
        for (int h = 0; h < 4; ++h) { f32x4 v[8];
#pragma unroll
            for (int r = 0; r < 8; ++r) v[r] = wp[(size_t)(rg + 32 * (8 * h + r)) * (INW / 4)];
#pragma unroll
            for (int r = 0; r < 8; ++r) { mx[0] = fmaxf(mx[0], fabsf(v[r][0])); mx[1] = fmaxf(mx[1], fabsf(v[r][1])); mx[2] = fmaxf(mx[2], fabsf(v[r][2])); mx[3] = fmaxf(mx[3], fabsf(v[r][3])); } }
        __syncthreads();
        red[rg * 16 + cq] = mx;
        __syncthreads();
        if (tid < 64) { const LAS float* rf = (const LAS float*)red; float m = 0.f;
#pragma unroll
            for (int g = 0; g < 32; ++g) m = fmaxf(m, rf[g * 64 + tid]);
            F.wmax()[l * INW + cb * 64 + tid] = __float_as_uint(m); }
      }
    }
    if (F.bid == F.G - 1) {
        for (int i = tid; i < 1024; i += NTHREADS) { const int pos = i >> 4, fi = i & 15; const double c1 = ROPE_CS[fi][0], s1 = ROPE_CS[fi][1]; double c = 1.0, s = 0.0;
            for (int k = 0; k < pos; ++k) { const double cn = c * c1 - s * s1, sn = s * c1 + c * s1; c = cn; s = sn; }
            F.rope()[2 * i] = (float)c; F.rope()[2 * i + 1] = (float)s; }
    }
    LAS float* sv = (LAS float*)F.lds;
    for (int u = F.bid; u < 192; u += F.G) {
        __syncthreads();
        for (int i = tid; i < 33 * 1024; i += NTHREADS) { const int r = i >> 10, k = i & 1023; const float c = (r < 32) ? F.P->in[I_C][r * 1024 + k] : F.P->in[I_CCTX][k]; sv[i] = c / (1.0f + __expf(-c)); }
        __syncthreads();
        const int l = u / 48, cg = u % 48;
        const f32x2* W = (const f32x2*)(F.P->in[I_ADAW] + (size_t)l * 1024 * 6144 + cg * 128 + 2 * lane);
        f32x2 acc[33];
#pragma unroll
        for (int r = 0; r < 33; ++r) acc[r] = (f32x2){0.f, 0.f};
        f32x2 wq[16];
#pragma unroll
        for (int j = 0; j < 16; ++j) wq[j] = W[(size_t)(128 * w + j) * 3072];
        for (int k0 = 128 * w; k0 < 128 * w + 128; k0 += 16) {
            f32x2 wn[16]; const int kn = (k0 + 16 < 128 * w + 128) ? k0 + 16 : k0;
#pragma unroll
            for (int j = 0; j < 16; ++j) wn[j] = W[(size_t)(kn + j) * 3072];
            asm volatile("" ::: "memory");
#pragma unroll
            for (int q = 0; q < 4; ++q) {
#pragma unroll
                for (int r0 = 0; r0 < 33; r0 += 11) {
                    f32x4 s4[11];
#pragma unroll
                    for (int r = 0; r < 11; ++r) s4[r] = *(const LAS f32x4*)(sv + (r0 + r) * 1024 + k0 + 4 * q);
#pragma unroll
                    for (int r = 0; r < 11; ++r) {
                        acc[r0 + r] = __builtin_elementwise_fma((f32x2){s4[r][0], s4[r][0]}, wq[4 * q + 0], acc[r0 + r]); acc[r0 + r] = __builtin_elementwise_fma((f32x2){s4[r][1], s4[r][1]}, wq[4 * q + 1], acc[r0 + r]);
                        acc[r0 + r] = __builtin_elementwise_fma((f32x2){s4[r][2], s4[r][2]}, wq[4 * q + 2], acc[r0 + r]); acc[r0 + r] = __builtin_elementwise_fma((f32x2){s4[r][3], s4[r][3]}, wq[4 * q + 3], acc[r0 + r]); }
                    asm volatile("" ::: "memory"); __builtin_amdgcn_sched_barrier(0);
                }
            }
#pragma unroll
            for (int j = 0; j < 16; ++j) wq[j] = wn[j];
        }
        __syncthreads();
#pragma unroll
        for (int r = 0; r < 33; ++r) *(LAS f32x2*)(sv + (w * 33 + r) * 128 + 2 * lane) = acc[r];
        __syncthreads();
        for (int o = tid; o < 33 * 128; o += NTHREADS) { const int r = o >> 7, c = o & 127; float sum = 0.f;
#pragma unroll
            for (int ww = 0; ww < 8; ++ww) sum += sv[(ww * 33 + r) * 128 + c];
            const int nn = cg * 128 + c; F.mods()[(size_t)(l * 33 + r) * 6144 + nn] = sum + F.P->in[I_ADAB][l * 6144 + nn]; }
    }
    __syncthreads();
}

struct CvtTile { const float* src; bf16_t* dst; int ldn, k0, n0, mode; };
DI CvtTile cvt_desc(const Frame& F, int l, int t_) {
    const int t = __builtin_amdgcn_readfirstlane(t_);
    CvtTile c;
    if (t < 144) { const int nt_ = t >> 4, kt = t & 15; c.src = F.P->in[I_WIN] + (size_t)l * D * INW; c.ldn = INW; c.k0 = kt * 64; c.n0 = nt_ * 256; c.dst = F.WIN(); c.mode = 4; }
    else if (t < 208) { const int q = t - 144, nt_ = q >> 4, kt = q & 15; c.src = F.P->in[I_WOUT] + (size_t)l * D * D; c.ldn = D; c.k0 = kt * 64; c.n0 = nt_ * 256; c.dst = F.WOUT(); c.mode = 0; }
    else { const int q = t - 208, job = q >> 10, r = q & 1023, e = r >> 6, nt_ = (r >> 4) & 3, kt = r & 15;
        c.src = (job == 0 ? F.P->in[I_WGATE] : (job == 1 ? F.P->in[I_WUP] : F.P->in[I_WDOWN])) + (size_t)(l * NE + e) * D * D; c.ldn = D; c.k0 = kt * 64; c.n0 = nt_ * 256;
        c.dst = (bf16_t*)(job == 2 ? (unsigned char*)F.WD() + (size_t)e * D * D : (unsigned char*)F.WGU() + (size_t)e * 2 * D * D); c.mode = job + 1; }
    return c;
}
DI void cvt_load(const CvtTile& c, int tid, f32x4 (&v)[8]) {
#pragma unroll
    for (int i = 0; i < 8; ++i) { const int row = (tid >> 6) + 8 * i, c4 = (tid & 63) * 4; v[i] = *(const f32x4*)(c.src + (size_t)(c.k0 + row) * c.ldn + c.n0 + c4); }
}
DI void cvt_store(const Frame& F, const CvtTile& c, const f32x4 (&v)[8], const unsigned* colmax  ) {
    LAS float* T = (LAS float*)F.lds;
    const int tid = F.tid;
    __syncthreads();
#pragma unroll
    for (int i = 0; i < 8; ++i) { const int row = (tid >> 6) + 8 * i, c4 = (tid & 63) * 4; LAS float* tp = T + row * 257 + c4; tp[0] = v[i][0]; tp[1] = v[i][1]; tp[2] = v[i][2]; tp[3] = v[i][3]; }
    __syncthreads();
    if (c.mode == 0) {
#pragma unroll
        for (int j = 0; j < 4; ++j) { const int q = tid + NTHREADS * j, kc = q & 7, n = q >> 3; float x[8];
#pragma unroll
            for (int i = 0; i < 8; ++i) x[i] = T[(8 * kc + i) * 257 + n];
            u32x4 w; w.x = pk_bf16(x[0], x[1]); w.y = pk_bf16(x[2], x[3]); w.z = pk_bf16(x[4], x[5]); w.w = pk_bf16(x[6], x[7]);
            *(u32x4*)(c.dst + (size_t)(c.n0 + n) * D + c.k0 + 8 * kc) = w; }
    } else {
        unsigned char* d8 = (unsigned char*)c.dst;
#pragma unroll
        for (int j = 0; j < 2; ++j) { const int q = tid + NTHREADS * j, kc = q & 3, n = q >> 2; float x[16];
            const int ng = c.n0 + n; float qs = 64.0f;
            if (c.mode == 4) { const float cm = __uint_as_float(colmax[ng]); qs = cm > 0.f ? 127.0f / cm : 0.f; }
#pragma unroll
            for (int i = 0; i < 16; ++i) x[i] = T[(16 * kc + i) * 257 + n] * qs; const int drow = (c.mode == 3 || c.mode == 4) ? ng : (256 * (ng >> 7) + (ng & 127) + (c.mode == 2 ? 128 : 0));
            u32x4 w;
            if (c.mode == 4) { w.x = pk_i8x4(x[0], x[1], x[2], x[3]); w.y = pk_i8x4(x[4], x[5], x[6], x[7]); w.z = pk_i8x4(x[8], x[9], x[10], x[11]); w.w = pk_i8x4(x[12], x[13], x[14], x[15]); }
            else { w.x = pk_fp8x4(x[0], x[1], x[2], x[3]); w.y = pk_fp8x4(x[4], x[5], x[6], x[7]); w.z = pk_fp8x4(x[8], x[9], x[10], x[11]); w.w = pk_fp8x4(x[12], x[13], x[14], x[15]); }
            *(u32x4*)(d8 + (size_t)drow * D + c.k0 + 16 * kc) = w; }
    }
}
DI void convert_weights(const Frame& F0, int l) {
    const Frame F = refresh(F0);
    int t = F.bid;
    if (t < 3280) {
        f32x4 v[8]; { const CvtTile c0 = cvt_desc(F, l, t); cvt_load(c0, F.tid, v); }
        for (;;) {
            const int tn = t + F.G; const bool more = tn < 3280;
            f32x4 nv[8]; { const CvtTile nxt = cvt_desc(F, l, more ? tn : t); cvt_load(nxt, F.tid, nv); }
            asm volatile("" ::: "memory");
            { const CvtTile cur = cvt_desc(F, l, t); cvt_store(F, cur, v, F.wmax() + l * INW); }
            if (!more) break;
#pragma unroll
            for (int i = 0; i < 8; ++i) v[i] = nv[i];
            t = tn;
        }
    }
    __syncthreads();
}

template <bool X32> struct XRaw;
template <> struct XRaw<true>  { f32x4 v[4]; };
template <> struct XRaw<false> { u32x2 v[4]; };
DI void xload(XRaw<true>& r, const void* rowp, int lane) {
#pragma unroll
    for (int j = 0; j < 4; ++j) r.v[j] = *(const f32x4*)((const float*)rowp + 4 * lane + 256 * j); }
DI void xload(XRaw<false>& r, const void* rowp, int lane) {
#pragma unroll
    for (int j = 0; j < 4; ++j) r.v[j] = *(const u32x2*)((const bf16_t*)rowp + 4 * lane + 256 * j); }
DI void xcvt(const XRaw<true>& r, f32x4 (&x)[4]) {
#pragma unroll
    for (int j = 0; j < 4; ++j) x[j] = r.v[j]; }
DI void xcvt(const XRaw<false>& r, f32x4 (&x)[4]) {
#pragma unroll
    for (int j = 0; j < 4; ++j) x[j] = (f32x4){bf_lo(r.v[j].x), bf_hi(r.v[j].x), bf_lo(r.v[j].y), bf_hi(r.v[j].y)}; }
DI void xstore_bf16(bf16_t* rowp, const f32x4 (&x)[4], int lane) {
#pragma unroll
    for (int j = 0; j < 4; ++j) { u32x2 w; w.x = pk_bf16(x[j][0], x[j][1]); w.y = pk_bf16(x[j][2], x[j][3]); *(u32x2*)(rowp + 4 * lane + 256 * j) = w; } }

DI void combine_row(f32x4 (&x)[4], unsigned mask, int selv, int lanebase, const unsigned char* YD, size_t ybase  , size_t estride, const f32x4 (&g2)[4], int lane) {
    f32x4 a[4];
#pragma unroll
    for (int j = 0; j < 4; ++j) a[j] = (f32x4){0.f, 0.f, 0.f, 0.f};
    while (mask) {
        int e[4]; float wgt[4];
        e[0] = __builtin_ctz(mask); mask &= mask - 1; wgt[0] = 1.f;
#pragma unroll
        for (int k = 1; k < 4; ++k) { if (mask) { e[k] = __builtin_ctz(mask); mask &= mask - 1; wgt[k] = 1.f; } else { e[k] = e[0]; wgt[k] = 0.f; } }
        unsigned v[4][4];
#pragma unroll
        for (int k = 0; k < 4; ++k) { const int c = __builtin_amdgcn_readlane(selv, lanebase + e[k]); const unsigned char* yp = YD + (ybase + (size_t)e[k] * estride + (size_t)c) * D + 4 * lane;
#pragma unroll
            for (int j = 0; j < 4; ++j) v[k][j] = *(const unsigned*)(yp + 256 * j); }
#pragma unroll
        for (int k = 0; k < 4; ++k)
#pragma unroll
            for (int j = 0; j < 4; ++j) { const f32x2 lo = __builtin_amdgcn_cvt_pk_f32_fp8((int)v[k][j], false), hi = __builtin_amdgcn_cvt_pk_f32_fp8((int)v[k][j], true);
                a[j][0] += wgt[k] * lo[0]; a[j][1] += wgt[k] * lo[1]; a[j][2] += wgt[k] * hi[0]; a[j][3] += wgt[k] * hi[1]; }
    }
#pragma unroll
    for (int j = 0; j < 4; ++j) x[j] += g2[j] * a[j];
}
template <bool FIRST>
DI void phase_norm1(const Frame& F0, int l) {
    const Frame F = refresh(F0);
    const int lane = F.lane; const int gw = F.bid * 8 + F.wave, nw = F.G * 8;
    const bool fin = (l == NL);
    const int npairs = (fin ? NLAT : NTOK) / 2;
    const float* n1 = fin ? F.P->in[I_FINALG] : F.P->in[I_N1] + l * D;
    const float* const xin_lat = F.P->in[I_X]; const float* const xin_ctx = F.P->in[I_CTX]; bf16_t* const XB = F.xb();
#define XROWP(row) (FIRST ? (const void*)((row) >= NLAT ? xin_ctx + (size_t)((row) - NLAT) * D : xin_lat + (size_t)(row) * D) : (const void*)(XB + (size_t)(row) * D))
    float* const xlat = F.out(); bf16_t* const Hb = F.H(); float* const hsp = F.hs(); const unsigned char* const YD = (const unsigned char*)F.R1(); const short* const selb = F.sel(); const float* const modsb = F.mods();
    XRaw<FIRST> ra, rb; int selv = -1;
    const int per = (npairs + nw - 1) / nw, p_lo = gw * per, p_hi = (p_lo + per < npairs) ? p_lo + per : npairs;
    LAS f32x4* mv = (LAS f32x4*)(F.lds + F.wave * 12288) + lane; int curb = -1;
    if (p_lo < p_hi) { const int row = 2 * p_lo; xload(ra, XROWP(row), lane); xload(rb, XROWP(row + 1), lane);
        if (!FIRST && lane < 32) selv = (int)selb[(size_t)row * 16 + lane]; }
    for (int p = p_lo; p < p_hi; ++p) {
        const int row = 2 * p; const bool isctx = row >= NLAT; const int b = isctx ? (row - NLAT) >> 8 : row >> 11;
        f32x4 xa[4], xb[4]; xcvt(ra, xa); xcvt(rb, xb);
        const int mrow = isctx ? 32 : b;
        if (mrow != curb) {
            curb = mrow;
#pragma unroll
            for (int j = 0; j < 4; ++j) { f32x4 g = *(const f32x4*)(n1 + 4 * lane + 256 * j), sh0 = (f32x4){0.f, 0.f, 0.f, 0.f}, g20 = sh0;
                if (!fin) { const float* m = modsb + (size_t)(l * 33 + mrow) * 6144; sh0 = *(const f32x4*)(m + 4 * lane + 256 * j); g *= (*(const f32x4*)(m + 1024 + 4 * lane + 256 * j) + 1.0f); }
                if (!FIRST) { const float* mprev = modsb + (size_t)((l - 1) * 33 + mrow) * 6144 + 5 * 1024; g20 = *(const f32x4*)(mprev + 4 * lane + 256 * j) * pg8::YD_INV; }
                mv[(0 * 4 + j) * 64] = g; mv[(1 * 4 + j) * 64] = sh0; mv[(2 * 4 + j) * 64] = g20; }
        }
        unsigned ma = 0u, mb = 0u; int ea[4], eb[4]; float wa[4], wb[4]; unsigned va[4][4], vb[4][4];
        const size_t ybase = isctx ? (size_t)NXS_L + (size_t)b * CAP_C : (size_t)b * CAP_L; const size_t estride = isctx ? (size_t)NB * CAP_C : (size_t)NB * CAP_L;
        if (!FIRST) {
            const unsigned long long bal = __ballot(selv >= 0); ma = (unsigned)(bal & 0xffffull); mb = (unsigned)((bal >> 16) & 0xffffull);
#pragma unroll
            for (int k = 0; k < 4; ++k) { if (ma) { ea[k] = __builtin_ctz(ma); ma &= ma - 1; wa[k] = 1.f; } else { ea[k] = 0; wa[k] = 0.f; }
                                          if (mb) { eb[k] = __builtin_ctz(mb); mb &= mb - 1; wb[k] = 1.f; } else { eb[k] = 0; wb[k] = 0.f; } }
#pragma unroll
            for (int k = 0; k < 4; ++k) { int ca = __builtin_amdgcn_readlane(selv, ea[k]), cb = __builtin_amdgcn_readlane(selv, 16 + eb[k]); ca = ca < 0 ? 0 : ca; cb = cb < 0 ? 0 : cb;
                const unsigned char* ya = YD + (ybase + (size_t)ea[k] * estride + (size_t)ca) * D + 4 * lane; const unsigned char* yb = YD + (ybase + (size_t)eb[k] * estride + (size_t)cb) * D + 4 * lane;
#pragma unroll
                for (int j = 0; j < 4; ++j) { va[k][j] = *(const unsigned*)(ya + 256 * j); vb[k][j] = *(const unsigned*)(yb + 256 * j); } }
        }
        asm volatile("" ::: "memory");
        XRaw<FIRST> na, nb; int nsel = -1;
        { const int pn = p + 1; const int rown = 2 * (pn < p_hi ? pn : p); xload(na, XROWP(rown), lane); xload(nb, XROWP(rown + 1), lane);
          if (!FIRST && lane < 32) nsel = (int)selb[(size_t)rown * 16 + lane]; }
        asm volatile("" ::: "memory");
        if (!FIRST) {
            f32x4 g2[4];
#pragma unroll
            for (int j = 0; j < 4; ++j) g2[j] = mv[(2 * 4 + j) * 64];
            f32x4 aa[4], ab[4];
#pragma unroll
            for (int j = 0; j < 4; ++j) { aa[j] = (f32x4){0.f, 0.f, 0.f, 0.f}; ab[j] = aa[j]; }
#pragma unroll
            for (int k = 0; k < 4; ++k)
#pragma unroll
                for (int j = 0; j < 4; ++j) { const f32x2 al = __builtin_amdgcn_cvt_pk_f32_fp8((int)va[k][j], false), ah = __builtin_amdgcn_cvt_pk_f32_fp8((int)va[k][j], true), bl = __builtin_amdgcn_cvt_pk_f32_fp8((int)vb[k][j], false), bh = __builtin_amdgcn_cvt_pk_f32_fp8((int)vb[k][j], true);
                    aa[j][0] += wa[k] * al[0]; aa[j][1] += wa[k] * al[1]; aa[j][2] += wa[k] * ah[0]; aa[j][3] += wa[k] * ah[1];
                    ab[j][0] += wb[k] * bl[0]; ab[j][1] += wb[k] * bl[1]; ab[j][2] += wb[k] * bh[0]; ab[j][3] += wb[k] * bh[1]; }
#pragma unroll
            for (int j = 0; j < 4; ++j) { xa[j] += g2[j] * aa[j]; xb[j] += g2[j] * ab[j]; }
            if (ma) combine_row(xa, ma, selv, 0, YD, ybase, estride, g2, lane);
            if (mb) combine_row(xb, mb, selv, 16, YD, ybase, estride, g2, lane);
            if (!fin) { xstore_bf16(XB + (size_t)row * D, xa, lane); xstore_bf16(XB + (size_t)(row + 1) * D, xb, lane); }
        }
        float ssa = 0.f, ssb = 0.f;
#pragma unroll
        for (int j = 0; j < 4; ++j) { ssa += xa[j][0] * xa[j][0] + xa[j][1] * xa[j][1] + xa[j][2] * xa[j][2] + xa[j][3] * xa[j][3]; ssb += xb[j][0] * xb[j][0] + xb[j][1] * xb[j][1] + xb[j][2] * xb[j][2] + xb[j][3] * xb[j][3]; }
        ssa = wave_sum(ssa); ssb = wave_sum(ssb);
        const float rsa = rsqrtf(ssa * (1.0f / D) + EPS), rsb = rsqrtf(ssb * (1.0f / D) + EPS);
        if (fin) {
            float* o = xlat + (size_t)row * D;
#pragma unroll
            for (int j = 0; j < 4; ++j) { const f32x4 g = mv[(0 * 4 + j) * 64]; *(f32x4*)(o + 4 * lane + 256 * j) = xa[j] * rsa * g; *(f32x4*)(o + D + 4 * lane + 256 * j) = xb[j] * rsb * g; }
        } else {
            float ma = 0.f, mb = 0.f;
#pragma unroll
            for (int j = 0; j < 4; ++j) { const f32x4 g = mv[(0 * 4 + j) * 64], sh0 = mv[(1 * 4 + j) * 64]; const f32x4 ha = xa[j] * rsa * g + sh0, hb = xb[j] * rsb * g + sh0;
                ma = fmaxf(ma, fmaxf(fmaxf(fabsf(ha[0]), fabsf(ha[1])), fmaxf(fabsf(ha[2]), fabsf(ha[3])))); mb = fmaxf(mb, fmaxf(fmaxf(fabsf(hb[0]), fabsf(hb[1])), fmaxf(fabsf(hb[2]), fabsf(hb[3])))); }
            ma = wave_max(ma); mb = wave_max(mb);
            ma = fmaxf(ma, 1e-20f); mb = fmaxf(mb, 1e-20f);
            const float qa = 127.0f / ma, qb = 127.0f / mb;
            if (lane == 0) { hsp[row] = ma * (1.0f / 127.0f); hsp[row + 1] = mb * (1.0f / 127.0f); }
            unsigned char* hp = (unsigned char*)Hb + (size_t)row * D + 4 * lane;
#pragma unroll
            for (int j = 0; j < 4; ++j) { const f32x4 g = mv[(0 * 4 + j) * 64], sh0 = mv[(1 * 4 + j) * 64]; const f32x4 ha = (xa[j] * rsa * g + sh0) * qa, hb = (xb[j] * rsb * g + sh0) * qb;
                *(unsigned*)(hp + 256 * j) = pk_i8x4(ha[0], ha[1], ha[2], ha[3]); *(unsigned*)(hp + D + 256 * j) = pk_i8x4(hb[0], hb[1], hb[2], hb[3]); }
        }
        ra = na; rb = nb;
        selv = nsel;
    }
#undef XROWP
}

DI float logits_transpose_reduce(const float (&v)[16], int lane) {
    const bool b3 = lane & 8, b2 = lane & 4;
    float a8[8], a4[4], a2[2];
#pragma unroll
    for (int i = 0; i < 8; ++i) { float x = v[i], y = v[8 + i]; swap32(x, y); a8[i] = x + y; }
#pragma unroll
    for (int i = 0; i < 4; ++i) { float x = a8[i], y = a8[4 + i]; swap16(x, y); a4[i] = x + y; }
#pragma unroll
    for (int i = 0; i < 2; ++i) { const float send = b3 ? a4[i] : a4[2 + i], keep = b3 ? a4[2 + i] : a4[i]; a2[i] = keep + dpp_mov<DPP_MIR>(send); }
    float r = (b2 ? a2[1] : a2[0]) + dpp_mov<DPP_HMIR>(b2 ? a2[0] : a2[1]);
    r += dpp_mov<DPP_X1>(r); r += dpp_mov<DPP_X2>(r);
    return r;
}
DI float xlane16_max(float v) { return wave_max(v); }
DI float xlane16_sum(float v) { return 0.25f * wave_sum(v); }

DI void router_pair(const f32x4 (&xa)[4], const f32x4 (&xb)[4], float rsa, float rsb, const LAS f32x4* mv, unsigned char* hp, const LAS float* R, int lane, float& lga, float& lgb) {
    float la[16], lb[16];
#pragma unroll
    for (int e = 0; e < 16; ++e) { la[e] = 0.f; lb[e] = 0.f; }
    const LAS f32x4* Rl = (const LAS f32x4*)R + lane;
    f32x4 rv[4];
#pragma unroll
    for (int eq = 0; eq < 4; ++eq) rv[eq] = Rl[eq * 64];
#pragma unroll
    for (int j = 0; j < 4; ++j) {
        const f32x4 gs = mv[(0 * 4 + j) * 64], sh = mv[(1 * 4 + j) * 64];
        const f32x4 ha = xa[j] * rsa * gs + sh, hb = xb[j] * rsb * gs + sh;
        *(unsigned*)(hp + 256 * j) = pk_fp8x4(ha[0], ha[1], ha[2], ha[3]); *(unsigned*)(hp + D + 256 * j) = pk_fp8x4(hb[0], hb[1], hb[2], hb[3]);
#pragma unroll
        for (int i = 0; i < 4; ++i) { const int g = j * 4 + i; f32x4 nv[4];
#pragma unroll
            for (int eq = 0; eq < 4; ++eq) nv[eq] = Rl[(((g + 1) & 15) * 4 + eq) * 64];
            __builtin_amdgcn_sched_barrier(0);
#pragma unroll
            for (int eq = 0; eq < 4; ++eq) { la[4 * eq + 0] += ha[i] * rv[eq][0]; la[4 * eq + 1] += ha[i] * rv[eq][1]; la[4 * eq + 2] += ha[i] * rv[eq][2]; la[4 * eq + 3] += ha[i] * rv[eq][3];
                                             lb[4 * eq + 0] += hb[i] * rv[eq][0]; lb[4 * eq + 1] += hb[i] * rv[eq][1]; lb[4 * eq + 2] += hb[i] * rv[eq][2]; lb[4 * eq + 3] += hb[i] * rv[eq][3]; }
#pragma unroll
            for (int eq = 0; eq < 4; ++eq) rv[eq] = nv[eq];
            asm volatile("" ::: "memory"); __builtin_amdgcn_sched_barrier(0); } }
    lga = logits_transpose_reduce(la, lane); lgb = logits_transpose_reduce(lb, lane);
}
template <bool FIRST>
DI void phase_norm2_router(const Frame& F0, int l) {
    const Frame F = refresh(F0);
    const int lane = F.lane, tid = F.tid; const int gw = F.bid * 8 + F.wave, nw = F.G * 8;
    LAS float* R = (LAS float*)F.lds;
    __syncthreads();
    { const float* rw = F.P->in[I_ROUTER] + (size_t)l * D * NE;
      for (int idx = tid; idx < D * NE; idx += NTHREADS) { const int c = idx >> 4, e = idx & 15, ln = (c & 255) >> 2, i = c & 3, j = c >> 8, eq = e >> 2, ee = e & 3;
          R[((((j * 4 + i) * 4 + eq) * 64 + ln) << 2) + ee] = rw[idx]; } }
    __syncthreads();
    const int npairs = ((l == NL - 1) ? NLAT : NTOK) / 2;
    const float* n2 = F.P->in[I_N2] + l * D;
    bf16_t* const XB = F.xb(); const bf16_t* const DL = F.R1(); bf16_t* const Hb = F.H(); float* const affp = F.aff(); const float* const modsl = F.mods() + (size_t)l * 33 * 6144;
    const float* const xin_lat = F.P->in[I_X]; const float* const xin_ctx = F.P->in[I_CTX];
#define XROWP(row) (FIRST ? (const void*)((row) >= NLAT ? xin_ctx + (size_t)((row) - NLAT) * D : xin_lat + (size_t)(row) * D) : (const void*)(XB + (size_t)(row) * D))
    XRaw<FIRST> ra, rb; XRaw<false> da, db;
    const int per = (npairs + nw - 1) / nw, p_lo = gw * per, p_hi = (p_lo + per < npairs) ? p_lo + per : npairs;
    LAS f32x4* mv = (LAS f32x4*)(F.lds + 65536 + F.wave * 8192) + lane; int curb = -1;
    if (p_lo < p_hi) { const int row = 2 * p_lo; xload(ra, XROWP(row), lane); xload(rb, XROWP(row + 1), lane); xload(da, DL + (size_t)row * D, lane); xload(db, DL + (size_t)(row + 1) * D, lane); }
    for (int p = p_lo; p < p_hi; ++p) {
        const int row = 2 * p; const bool isctx = row >= NLAT; const int b = isctx ? (row - NLAT) >> 8 : row >> 11; const int t = isctx ? (row - NLAT) & 255 : row & 2047;
        f32x4 xa[4], xb[4]; xcvt(ra, xa); xcvt(rb, xb);
        { f32x4 ta[4], tb[4]; xcvt(da, ta); xcvt(db, tb);
#pragma unroll
          for (int j = 0; j < 4; ++j) { xa[j] += ta[j]; xb[j] += tb[j]; } }
        xstore_bf16(XB + (size_t)row * D, xa, lane); xstore_bf16(XB + (size_t)(row + 1) * D, xb, lane);
        const int mrow = isctx ? 32 : b;
        if (mrow != curb) { curb = mrow; const float* m = modsl + (size_t)mrow * 6144 + 3 * 1024;
#pragma unroll
            for (int j = 0; j < 4; ++j) { mv[(1 * 4 + j) * 64] = *(const f32x4*)(m + 4 * lane + 256 * j); mv[(0 * 4 + j) * 64] = (*(const f32x4*)(m + 1024 + 4 * lane + 256 * j) + 1.0f) * *(const f32x4*)(n2 + 4 * lane + 256 * j); } }
        XRaw<FIRST> na, nb; XRaw<false> dna, dnb;
        { const int pn = p + 1; const int rown = 2 * (pn < p_hi ? pn : p); xload(na, XROWP(rown), lane); xload(nb, XROWP(rown + 1), lane); xload(dna, DL + (size_t)rown * D, lane); xload(dnb, DL + (size_t)(rown + 1) * D, lane); }
        asm volatile("" ::: "memory");
        float ssa = 0.f, ssb = 0.f;
#pragma unroll
        for (int j = 0; j < 4; ++j) { ssa += xa[j][0] * xa[j][0] + xa[j][1] * xa[j][1] + xa[j][2] * xa[j][2] + xa[j][3] * xa[j][3]; ssb += xb[j][0] * xb[j][0] + xb[j][1] * xb[j][1] + xb[j][2] * xb[j][2] + xb[j][3] * xb[j][3]; }
        ssa = wave_sum(ssa); ssb = wave_sum(ssb);
        const float rsa = rsqrtf(ssa * (1.0f / D) + EPS), rsb = rsqrtf(ssb * (1.0f / D) + EPS);
        unsigned char* hp = (unsigned char*)Hb + (size_t)row * D + 4 * lane;
        float lga, lgb; router_pair(xa, xb, rsa, rsb, mv, hp, R, lane, lga, lgb);
        __builtin_amdgcn_sched_barrier(0);
        const float ea = __expf(lga - xlane16_max(lga)), eb = __expf(lgb - xlane16_max(lgb));
        const float pa = ea / xlane16_sum(ea), pb = eb / xlane16_sum(eb);
        if ((lane & 3) == 0) { const int e = lane >> 2; float* ap = isctx ? affp + (size_t)NB * NE * SEQ + (size_t)(b * NE + e) * CTX + t : affp + (size_t)(b * NE + e) * SEQ + t; ap[0] = pa; ap[1] = pb; }
        ra = na; rb = nb; da = dna; db = dnb;
    }
#undef XROWP
    __syncthreads();
}

typedef unsigned long long u64;
DI void cmpx(u64& a, u64& b, bool desc) { const bool sw = desc ? (a < b) : (a > b); const u64 t = sw ? b : a; b = sw ? a : b; a = t; }
template <int N  >
DI void bitonic4(u64 (&k)[4], int t, int lane, LAS u64* xbuf  ) {
    int lpass = 0;
    for (int k2 = 2; k2 <= N; k2 <<= 1) {
        for (int j = k2 >> 1; j > 0; j >>= 1) {
            if (j >= 256) {
                if (N > 256) {
                    LAS u64* xb = xbuf + (lpass & 1) * 2048; ++lpass;
                    *(LAS u32x4*)(xb + 4 * t) = __builtin_bit_cast(u32x4, (unsigned long long __attribute__((ext_vector_type(2)))){k[0], k[1]});
                    *(LAS u32x4*)(xb + 4 * t + 2) = __builtin_bit_cast(u32x4, (unsigned long long __attribute__((ext_vector_type(2)))){k[2], k[3]});
                    __syncthreads();
                    const int p = t ^ (j >> 2); const bool lower = (t & (j >> 2)) == 0, up = ((4 * t) & k2) == 0;
                    const u32x4 q0 = *(const LAS u32x4*)(xb + 4 * p), q1 = *(const LAS u32x4*)(xb + 4 * p + 2);
                    const u64 b[4] = {((u64)q0.y << 32) | q0.x, ((u64)q0.w << 32) | q0.z, ((u64)q1.y << 32) | q1.x, ((u64)q1.w << 32) | q1.z};
#pragma unroll
                    for (int e = 0; e < 4; ++e) { const u64 mx = k[e] > b[e] ? k[e] : b[e], mn = k[e] > b[e] ? b[e] : k[e]; k[e] = (lower == up) ? mx : mn; }
                }
            } else if (j >= 4) {
                const int m = j >> 2; const bool lower = (t & m) == 0, up = ((4 * t) & k2) == 0;
#pragma unroll
                for (int e = 0; e < 4; ++e) { const unsigned lo = (unsigned)k[e], hi = (unsigned)(k[e] >> 32);
                    const u64 b = ((u64)(unsigned)__shfl_xor((int)hi, m) << 32) | (unsigned)__shfl_xor((int)lo, m);
                    const u64 mx = k[e] > b ? k[e] : b, mn = k[e] > b ? b : k[e]; k[e] = (lower == up) ? mx : mn; }
            } else if (j == 2) {
                const bool up = ((4 * t) & k2) == 0 || k2 < 4;
                const bool up4 = (k2 == 4) ? ((t & 1) == 0) : (((4 * t) & k2) == 0);
                (void)up; cmpx(k[0], k[2], up4); cmpx(k[1], k[3], up4);
            } else {
                if (k2 == 2) { cmpx(k[0], k[1], true); cmpx(k[2], k[3], false); }
                else { const bool up4 = (k2 == 4) ? ((t & 1) == 0) : (((4 * t) & k2) == 0); cmpx(k[0], k[1], up4); cmpx(k[2], k[3], up4); }
            }
        }
    }
}
DI void topk_emit(const Frame& F, const u64 (&k)[4], int t, bool isctx, int b, int e, int T, int cap) {
    const size_t rowbase = isctx ? (size_t)NXS_L + (size_t)(e * NB + b) * CAP_C : (size_t)(e * NB + b) * CAP_L;
    short* sp = F.sel() + (isctx ? (size_t)NLAT * 16 + (size_t)b * CTX * 16 : (size_t)b * SEQ * 16) + e;
#pragma unroll
    for (int q = 0; q < 4; ++q) { const int pos = 4 * t + q; const int tok = T - 1 - (int)(unsigned)(k[q] & 0xffffffffull);
        sp[(size_t)tok * 16] = (short)(pos < cap ? pos : -1);
        if (pos < cap) { F.gate()[rowbase + pos] = __uint_as_float((unsigned)(k[q] >> 32)); F.idx()[rowbase + pos] = (isctx ? NLAT + b * CTX : b * SEQ) + tok; } }
}
DI void wg_prefix4(const int (&f)[4], int (&out)[4], LAS unsigned* wtot, int lane, int w) {
    int below = 0, tot = 0;
#pragma unroll
    for (int q = 0; q < 4; ++q) { const u64 m = __ballot(f[q] != 0); below += (int)__builtin_amdgcn_mbcnt_hi((unsigned)(m >> 32), __builtin_amdgcn_mbcnt_lo((unsigned)m, 0u)); tot += __popcll(m); }
    if (lane == 0) wtot[w] = (unsigned)tot;
    __syncthreads();
    int run = below;
#pragma unroll
    for (int i = 0; i < 8; ++i) run += (i < w) ? (int)wtot[i] : 0;
#pragma unroll
    for (int q = 0; q < 4; ++q) { out[q] = run; run += f[q]; }
}
DI void topk_select2048(const Frame& F, const float* ap, int b, int e) {
    const int tid = F.tid, lane = F.lane, w = F.wave;
    LAS unsigned* hist = (LAS unsigned*)F.lds;
    LAS unsigned* wtot = hist + 3072;
    const f32x4 a4 = *(const f32x4*)(ap + 4 * tid);
#pragma unroll
    for (int i = 0; i < 6; ++i) hist[tid + NTHREADS * i] = 0u;
    unsigned key[4];
    unsigned kclamp, kmask; int need;
    asm volatile("s_mov_b32 %0, 0x3fffffff\n\ts_mov_b32 %1, 0x3ff\n\ts_movk_i32 %2, 0x100" : "=s"(kclamp), "=s"(kmask), "=s"(need));
#pragma unroll
    for (int q = 0; q < 4; ++q) { const unsigned u = __float_as_uint(a4[q]); key[q] = u < kclamp ? u : kclamp; }
    __syncthreads();
    unsigned prefix = 0u; int eqc = 0;
#pragma unroll
    for (int p = 0; p < 3; ++p) {
        const int sh = 20 - 10 * p;
        LAS unsigned* h = hist + 1024 * p;
#pragma unroll
        for (int q = 0; q < 4; ++q) if (p == 0 || (key[q] >> (sh + 10)) == prefix) __hip_atomic_fetch_add(h + ((key[q] >> sh) & kmask), 1u, __ATOMIC_RELAXED, __HIP_MEMORY_SCOPE_WORKGROUP);
        __syncthreads();
        unsigned c[16];
#pragma unroll
        for (int i = 0; i < 4; ++i) { const u32x4 v = *(const LAS u32x4*)(h + 16 * lane + 4 * i); c[4 * i] = v.x; c[4 * i + 1] = v.y; c[4 * i + 2] = v.z; c[4 * i + 3] = v.w; }
        int s = 0;
#pragma unroll
        for (int i = 0; i < 16; ++i) s += (int)c[i];
        int incl = s;
#pragma unroll
        for (int d = 1; d < 64; d <<= 1) { const int t = __shfl_down(incl, d); incl += (lane + d < 64) ? t : 0; }
        const int S = incl - s;
        int bin = -1, above = 0, cnt = 0, run = S;
#pragma unroll
        for (int i = 15; i >= 0; --i) { const bool take = (bin < 0) && (run + (int)c[i] >= need); above = take ? run : above; cnt = take ? (int)c[i] : cnt; bin = take ? i : bin; run += (int)c[i]; }
        const bool hit = (S < need) && (bin >= 0);
        const int src = __ffsll((long long)__ballot(hit)) - 1;
        const int dsel = __shfl(16 * lane + bin, src); above = __shfl(above, src); eqc = __shfl(cnt, src);
        prefix = (prefix << 10) | (unsigned)dsel; need -= above;
    }
    int sl[4], eq[4];
#pragma unroll
    for (int q = 0; q < 4; ++q) { sl[q] = key[q] > prefix ? 1 : 0; eq[q] = key[q] == prefix ? 1 : 0; }
    if (eqc != need) {
        int er[4]; wg_prefix4(eq, er, wtot, lane, w);
#pragma unroll
        for (int q = 0; q < 4; ++q) eq[q] = (eq[q] && er[q] < need) ? 1 : 0;
    }
#pragma unroll
    for (int q = 0; q < 4; ++q) sl[q] |= eq[q];
    int pos[4]; wg_prefix4(sl, pos, wtot + 8, lane, w);
    const size_t rowbase = (size_t)(e * NB + b) * CAP_L;
    short* sp = F.sel() + (size_t)b * SEQ * 16 + e;
#pragma unroll
    for (int q = 0; q < 4; ++q) { const int tok = 4 * tid + q;
        sp[(size_t)tok * 16] = (short)(sl[q] ? pos[q] : -1);
        if (sl[q]) { F.gate()[rowbase + pos[q]] = a4[q]; F.idx()[rowbase + pos[q]] = b * SEQ + tok; } }
}
DI void phase_topk(const Frame& F0, int l) {
    const Frame F = refresh(F0);
    const int tid = F.tid, lane = F.lane, w = F.wave;
    LAS u64* xbuf = (LAS u64*)F.lds;
    __syncthreads();
    for (int u = F.bid; u < NB * NE; u += F.G) {
        const int b = u >> 4, e = u & 15;
        topk_select2048(F, F.aff() + (size_t)u * SEQ, b, e);
        __syncthreads();
    }
    if (l < NL - 1) {
        for (int u = F.bid * 8 + w; u < NB * NE; u += F.G * 8) {
            const int b = u >> 4, e = u & 15;
            const float* ap = F.aff() + (size_t)NB * NE * SEQ + (size_t)u * CTX;
            u64 k[4];
            { const f32x4 a4 = *(const f32x4*)(ap + 4 * lane);
#pragma unroll
              for (int q = 0; q < 4; ++q) k[q] = ((u64)__float_as_uint(a4[q]) << 32) | (unsigned)(CTX - 1 - (4 * lane + q)); }
            bitonic4<256>(k, lane, lane, xbuf);
            topk_emit(F, k, lane, true, b, e, CTX, CAP_C);
        }
    }
    __syncthreads();
}

DI void phase_prep(const Frame& F0, int l) {
    const Frame F = refresh(F0);
    const int tid = F.tid, lane = F.lane, w = F.wave;
    constexpr int UROWS = 62, U_BYTES = UROWS * 1024, WP_BYTES = 37 * 1024, VS_OFF = U_BYTES + WP_BYTES, RP_OFF = VS_OFF + 16640;
    LAS float* U = (LAS float*)F.lds; LAS float* Wp = (LAS float*)(F.lds + U_BYTES); LAS unsigned char* VS = F.lds + VS_OFF; LAS float* RP = (LAS float*)(F.lds + RP_OFF);
    const bf16_t* P = F.R1();
    bf16_t* const Yb = F.Y();
    __syncthreads();
    { const float* cb = F.P->in[I_CBW] + (size_t)l * 31 * 256; for (int i = tid; i < 37 * 256; i += NTHREADS) { const int k = (i >> 8) - 3; Wp[i] = (k >= 0 && k < 31) ? cb[k * 256 + (i & 255)] : 0.f; } }
    const f32x4 cbias = *(const f32x4*)(F.P->in[I_CBB] + l * 256 + 4 * lane), lng = *(const f32x4*)(F.P->in[I_CLNG] + l * 256 + 4 * lane), lnb = *(const f32x4*)(F.P->in[I_CLNB] + l * 256 + 4 * lane);
    f32x4 wa[3];
#pragma unroll
    for (int k = 0; k < 3; ++k) wa[k] = *(const f32x4*)(F.P->in[I_CAW] + (size_t)(l * 3 + k) * 256 + 4 * lane);
    const int hd = lane >> 2, sub = lane & 3, half = sub >> 1, qq = sub & 1;
    const int hdc = hd < 12 ? hd : 11;
    const int srccol = hdc < 4 ? 1280 + 64 * hdc : (hdc < 6 ? 1536 + 64 * (hdc - 4) : (hdc < 10 ? 1792 + 64 * (hdc - 6) : 2048 + 64 * (hdc - 10)));
    const bool isq = hdc < 4 || (hdc >= 6 && hdc < 10), isD = hdc >= 6;
    const int c1 = srccol + 32 * half + 8 * qq;
    float g1v[8], g2v[8];
    { const float* gg = (isq ? F.P->in[I_QNG] : F.P->in[I_KNG]) + l * 64 + 32 * half + 8 * qq;
#pragma unroll
      for (int i = 0; i < 8; ++i) { g1v[i] = isD ? gg[i] : 1.0f; g2v[i] = isD ? gg[16 + i] : 1.0f; } }
    const float qscale = isq ? 0.125f * LOG2E : 1.0f;
    { const float* const ropet = F.rope(); for (int i = tid; i < 64 * 16 * 2; i += NTHREADS) RP[i] = ropet[i]; }

    u32x2 bvr[8], bgr[8]; u32x4 vr[2];
#define PREP_LOAD_A(uu) do { const bool ic_ = (uu) >= 2048; const int b_ = ic_ ? ((uu) - 2048) >> 3 : (uu) >> 6, ch_ = ic_ ? ((uu) - 2048) & 7 : (uu) & 63, T_ = ic_ ? CTX : SEQ, t0_ = ch_ * 32; \
        const size_t rb_ = ic_ ? (size_t)NLAT + (size_t)b_ * CTX : (size_t)b_ * SEQ; \
        _Pragma("unroll") for (int it = 0; it < 8; ++it) { const int idx = tid + NTHREADS * it, rr = idx >> 6, c4 = (idx & 63) * 4; int t = t0_ - 15 + rr; t = t < 0 ? 0 : (t > T_ - 1 ? T_ - 1 : t); \
            const bf16_t* pr = P + (rb_ + t) * INW; bvr[it] = *(const u32x2*)(pr + 768 + c4); bgr[it] = *(const u32x2*)(pr + 1024 + c4); } \
        _Pragma("unroll") for (int it = 0; it < 2; ++it) { const int idx = tid + NTHREADS * it, tl = idx >> 5, c16 = idx & 31, vc = 8 * c16; const int pc = vc < 128 ? 1664 + vc : 2176 + (vc - 128); \
            vr[it] = *(const u32x4*)(P + (rb_ + t0_ + tl) * INW + pc); } } while (0)
    if (F.bid < 2304) PREP_LOAD_A(F.bid);
    for (int u = F.bid; u < 2304; u += F.G) {
        const bool isctx = u >= 2048; const int b = isctx ? (u - 2048) >> 3 : u >> 6; const int ch = isctx ? (u - 2048) & 7 : u & 63;
        const int T = isctx ? CTX : SEQ, t0 = ch * 32; const size_t rowbase = isctx ? (size_t)NLAT + (size_t)b * CTX : (size_t)b * SEQ;
        const int posbase = isctx ? SEQ : 0;
        __syncthreads();
        {
#pragma unroll
            for (int it = 0; it < 8; ++it) { const int idx = tid + NTHREADS * it, rr = idx >> 6, c4 = (idx & 63) * 4, t = t0 - 15 + rr; const bool inr = t >= 0 && t < T; const u32x2 bv = bvr[it], bg = bgr[it]; f32x4 uv;
                uv[0] = bf_lo(bv.x) * fast_sigmoid(bf_lo(bg.x)); uv[1] = bf_hi(bv.x) * fast_sigmoid(bf_hi(bg.x)); uv[2] = bf_lo(bv.y) * fast_sigmoid(bf_lo(bg.y)); uv[3] = bf_hi(bv.y) * fast_sigmoid(bf_hi(bg.y));
                if (!inr) uv = (f32x4){0.f, 0.f, 0.f, 0.f};
                if (rr < UROWS) *(LAS f32x4*)(U + rr * 256 + c4) = uv; }
#pragma unroll
            for (int it = 0; it < 2; ++it) { const int idx = tid + NTHREADS * it, tl = idx >> 5, c16 = idx & 31; LAS unsigned* dp = (LAS unsigned*)(VS + tl * 516 + 16 * c16); dp[0] = vr[it].x; dp[1] = vr[it].y; dp[2] = vr[it].z; dp[3] = vr[it].w; }
        }
        __syncthreads();
        const int tb = t0 + 4 * w;
        u32x2 acr[6], ahr[6], abr[4]; u32x4 ra[4], rb[4];
#pragma unroll
        for (int rr = 0; rr < 6; ++rr) { int t = tb - 1 + rr; t = t < 0 ? 0 : (t > T - 1 ? T - 1 : t);
            const bf16_t* pr = P + (rowbase + t) * INW; acr[rr] = *(const u32x2*)(pr + 256 + 4 * lane); ahr[rr] = *(const u32x2*)(pr + 512 + 4 * lane); }
#pragma unroll
        for (int jj = 0; jj < 4; ++jj) { const bf16_t* pr = P + (rowbase + tb + jj) * INW; abr[jj] = *(const u32x2*)(pr + 4 * lane);
            ra[jj] = *(const u32x4*)(pr + c1); rb[jj] = *(const u32x4*)(pr + c1 + 16); }
        asm volatile("" ::: "memory");
        { const int un = (u + F.G < 2304) ? u + F.G : u; PREP_LOAD_A(un); }
        asm volatile("" ::: "memory");
        {
            const int tl0 = 4 * w;
            f32x4 acc0 = cbias, acc1 = cbias, acc2 = cbias, acc3 = cbias;
            f32x4 w1 = (f32x4){0.f, 0.f, 0.f, 0.f}, w2 = w1, w3 = w1;
            const LAS float* up = U + tl0 * 256 + 4 * lane; const LAS float* wp = Wp + 3 * 256 + 4 * lane;
#pragma unroll 2
            for (int r = 0; r < 34; ++r) { const f32x4 uu = *(const LAS f32x4*)(up + r * 256); const f32x4 w0 = *(const LAS f32x4*)(wp + r * 256);
                acc0 += w0 * uu; acc1 += w1 * uu; acc2 += w2 * uu; acc3 += w3 * uu; w3 = w2; w2 = w1; w1 = w0; }
            f32x4 accs[4] = {acc0, acc1, acc2, acc3};
#pragma unroll
            for (int jj = 0; jj < 4; ++jj) { const f32x4 a = accs[jj];
                const float mu = wave_sum(a[0] + a[1] + a[2] + a[3]) * (1.0f / 256.0f);
                const f32x4 dlt = a - mu;
                const float var = wave_sum(dlt[0] * dlt[0] + dlt[1] * dlt[1] + dlt[2] * dlt[2] + dlt[3] * dlt[3]) * (1.0f / 256.0f);
                const float rs = rsqrtf(var + EPS);
                f32x4 y = dlt * rs * lng + lnb;
#pragma unroll
                for (int i = 0; i < 4; ++i) y[i] = y[i] * fast_sigmoid(y[i]);
                u32x2 o; o.x = pk_bf16(y[0], y[1]); o.y = pk_bf16(y[2], y[3]);
                *(u32x2*)(Yb + (rowbase + tb + jj) * D + 256 + 4 * lane) = o; }
        }
#pragma unroll
        for (int j = 0; j < 2; ++j) { const int q = tid + NTHREADS * j, tq = q & 3, vc = q >> 2; unsigned e8[8];
#pragma unroll
            for (int i = 0; i < 8; ++i) e8[i] = *(const LAS unsigned short*)(VS + (8 * tq + i) * 516 + 2 * vc);
            u32x4 o; o.x = e8[0] | (e8[1] << 16); o.y = e8[2] | (e8[3] << 16); o.z = e8[4] | (e8[5] << 16); o.w = e8[6] | (e8[7] << 16);
            const int grp = vc >> 7, kvh = (vc >> 6) & 1, d = vc & 63;
            bf16_t* dp = (grp ? F.VDT() : F.VCT()) + ((size_t)(b * 2 + kvh) * HD + d) * KPOS + posbase + t0 + 8 * tq;
            *(u32x4*)dp = o; }
        __builtin_amdgcn_sched_barrier(0);
        {
            f32x4 chv[6];
#pragma unroll
            for (int rr = 0; rr < 6; ++rr) { const u32x2 ac = acr[rr], ah = ahr[rr]; chv[rr] = (f32x4){bf_lo(ac.x) * bf_lo(ah.x), bf_hi(ac.x) * bf_hi(ah.x), bf_lo(ac.y) * bf_lo(ah.y), bf_hi(ac.y) * bf_hi(ah.y)}; }
            if (tb == 0) chv[0] = (f32x4){0.f, 0.f, 0.f, 0.f};
            if (tb + 4 == T) chv[5] = (f32x4){0.f, 0.f, 0.f, 0.f};
#pragma unroll
            for (int jj = 0; jj < 4; ++jj) { const size_t row = rowbase + tb + jj; const u32x2 ab = abr[jj];
                const f32x4 cv = wa[0] * chv[jj] + wa[1] * chv[jj + 1] + wa[2] * chv[jj + 2];
                u32x2 o; o.x = pk_bf16(bf_lo(ab.x) * cv[0], bf_hi(ab.x) * cv[1]); o.y = pk_bf16(bf_lo(ab.y) * cv[2], bf_hi(ab.y) * cv[3]);
                *(u32x2*)(Yb + row * D + 4 * lane) = o; }
        }
        __builtin_amdgcn_sched_barrier(0);
        if (lane < 48) {
#pragma unroll
            for (int jj = 0; jj < 4; ++jj) { const int t = tb + jj; const size_t row = rowbase + t;
                const u32x4 r1 = ra[jj], r2 = rb[jj];
                float x1[8], x2[8];
                x1[0] = bf_lo(r1.x); x1[1] = bf_hi(r1.x); x1[2] = bf_lo(r1.y); x1[3] = bf_hi(r1.y); x1[4] = bf_lo(r1.z); x1[5] = bf_hi(r1.z); x1[6] = bf_lo(r1.w); x1[7] = bf_hi(r1.w);
                x2[0] = bf_lo(r2.x); x2[1] = bf_hi(r2.x); x2[2] = bf_lo(r2.y); x2[3] = bf_hi(r2.y); x2[4] = bf_lo(r2.z); x2[5] = bf_hi(r2.z); x2[6] = bf_lo(r2.w); x2[7] = bf_hi(r2.w);
                float ss = 0.f;
#pragma unroll
                for (int i = 0; i < 8; ++i) ss += x1[i] * x1[i] + x2[i] * x2[i];
                ss += dpp_mov<DPP_X1>(ss); ss += dpp_mov<DPP_X2>(ss);
                const float rstd = isD ? rsqrtf(ss * (1.0f / 64.0f) + EPS) : 1.0f;
#pragma unroll
                for (int i = 0; i < 8; ++i) { x1[i] = x1[i] * rstd * g1v[i]; x2[i] = x2[i] * rstd * g2v[i]; }
                if (!isctx) { const int pos = half ? (t & 63) : (t >> 6); const LAS float* rp = RP + (pos * 16 + 8 * qq) * 2;
#pragma unroll
                    for (int i = 0; i < 8; ++i) { const float c = rp[2 * i], sn = rp[2 * i + 1]; const float o1 = x1[i] * c - x2[i] * sn, o2 = x2[i] * c + x1[i] * sn; x1[i] = o1; x2[i] = o2; } }
                u32x4 w1, w2;
                w1.x = pk_bf16(x1[0] * qscale, x1[1] * qscale); w1.y = pk_bf16(x1[2] * qscale, x1[3] * qscale); w1.z = pk_bf16(x1[4] * qscale, x1[5] * qscale); w1.w = pk_bf16(x1[6] * qscale, x1[7] * qscale);
                w2.x = pk_bf16(x2[0] * qscale, x2[1] * qscale); w2.y = pk_bf16(x2[2] * qscale, x2[3] * qscale); w2.z = pk_bf16(x2[4] * qscale, x2[5] * qscale); w2.w = pk_bf16(x2[6] * qscale, x2[7] * qscale);
                bf16_t* dp;
                if (isq) { const int hq = isD ? hdc - 6 : hdc; dp = (isD ? F.QD() : F.QC()) + row * 256 + hq * 64 + 32 * half + 8 * qq; }
                else { const int kvh = isD ? hdc - 10 : hdc - 4; dp = (isD ? F.KD() : F.KC()) + ((size_t)(b * 2 + kvh) * KPOS + posbase + t) * HD + 32 * half + 8 * qq; }
                *(u32x4*)dp = w1; *(u32x4*)(dp + 16) = w2; }
        }
    }
    __syncthreads();
}

constexpr int KT_STRIDE = 144, VT_STRIDE = 264, KT_BYTES = 128 * KT_STRIDE, VT_BYTES = 64 * VT_STRIDE, KV_BUF = KT_BYTES + VT_BYTES;
#ifndef GEMM_STAGGER
#define GEMM_STAGGER 0
#endif
#ifndef ATT_STAGGER
#define ATT_STAGGER 6
#endif
constexpr float ATT_THR = 6.0f;
struct AUnit { const bf16_t* Q; const bf16_t* K; const bf16_t* Vt; size_t qrow0; int kvh, jt0h, nloc2, nt2, qpos0, ycol; bool masked, use_sink, isD; };
DI AUnit attn_desc(const Frame& F, int u) {
    AUnit a; int b, qb;
    if (u < 1024) { b = u >> 5; a.kvh = (u >> 4) & 1; qb = u & 15; a.isD = true; a.jt0h = 0; a.nloc2 = 18; a.nt2 = 18; a.masked = false; a.qpos0 = 0; a.qrow0 = (size_t)b * SEQ + 128 * qb; }
    else if (u < 2048) { const int v = u - 1024; b = v >> 5; a.kvh = (v >> 4) & 1; qb = v & 15; a.isD = false; a.jt0h = qb > 0 ? qb - 1 : 0; a.nloc2 = (qb < 15 ? qb + 2 : 16) - a.jt0h; a.nt2 = a.nloc2 + 2; a.masked = true; a.qpos0 = 128 * qb; a.qrow0 = (size_t)b * SEQ + 128 * qb; }
    else { const int v = u - 2048; b = v >> 3; a.isD = (v >> 2) & 1; a.kvh = (v >> 1) & 1; qb = v & 1; a.jt0h = 0; a.nloc2 = 0; a.nt2 = 2; a.masked = false; a.qpos0 = 0; a.qrow0 = (size_t)NLAT + (size_t)b * CTX + 128 * qb; }
    a.Q = a.isD ? F.QD() : F.QC();
    a.K = (a.isD ? F.KD() : F.KC()) + (size_t)(b * 2 + a.kvh) * KPOS * HD; a.Vt = (a.isD ? F.VDT() : F.VCT()) + (size_t)(b * 2 + a.kvh) * HD * KPOS;
    a.use_sink = !a.isD; a.ycol = a.isD ? 768 : 512;
    return a;
}
#define ATT_SB() __builtin_amdgcn_sched_barrier(0)
template <bool NOMAX>
DI void attn_softmax(f32x16& s0, f32x16& o0, f32x16& o1, f32x16& negm, float& m, float& lsum, bf16x8 (&pf)[2], bool domask, int klo, int qpos0, int qr, int h) {
    if (!NOMAX) {
        if (domask) { const int kp0 = klo + 4 * h, qp = qpos0 + qr;
            if (klo < qpos0 - 1 || klo + 31 > qpos0 + 128) {
#pragma unroll
                for (int i = 0; i < 16; ++i) { const int kp = kp0 + (i & 3) + 8 * (i >> 2); const int d0 = qp - kp; s0[i] = (d0 > 128 || d0 < -128) ? -1e30f : s0[i]; } } }
        float mx = fmaxf(fmaxf(s0[0], s0[1]), fmaxf(s0[2], s0[3]));
#pragma unroll
        for (int i = 4; i < 16; i += 4) mx = fmaxf(mx, fmaxf(fmaxf(s0[i], s0[i + 1]), fmaxf(s0[i + 2], s0[i + 3])));
        mx = xor32_max(mx);
        if (__any(mx > ATT_THR)) {
            const float delta = fmaxf(mx, 0.0f), alpha = __builtin_amdgcn_exp2f(-delta);
            m += delta; lsum *= alpha;
#pragma unroll
            for (int i = 0; i < 16; ++i) { o0[i] *= alpha; o1[i] *= alpha; s0[i] -= delta; negm[i] = -m; }
        }
    }
    float ps = 0.f;
#pragma unroll
    for (int i = 0; i < 16; ++i) { s0[i] = __builtin_amdgcn_exp2f(s0[i]); ps += s0[i]; }
    lsum += ps;
    f32x8 t0, t1;
#pragma unroll
    for (int i = 0; i < 8; ++i) { t0[i] = s0[i]; t1[i] = s0[8 + i]; }
    pf[0] = __builtin_bit_cast(bf16x8, __builtin_convertvector(t0, bfv8)); pf[1] = __builtin_bit_cast(bf16x8, __builtin_convertvector(t1, bfv8));
}
template <bool NOMAX>
DI void attn_tile(LAS unsigned char* kb_, LAS unsigned char* vb_, const bf16x8 (&qf)[4], f32x16& o0, f32x16& o1, f32x16& negm, float& m, float& lsum,
                  bool domask, int klo0  , int qpos0, int qr, int r, int h) {
    bf16x8 ka[4]; u32x2 vl[2][2], vh[2][2]; f32x16 s0; bf16x8 pf[2];
#define ATT_KLOAD(st) do { _Pragma("unroll") for (int ks = 0; ks < 4; ++ks) ka[ks] = *(const LAS bf16x8*)(kb_ + (32 * (st) + r) * KT_STRIDE + 32 * ks + 16 * h); } while (0)
    ATT_KLOAD(0);
#pragma unroll
    for (int st = 0; st < 4; ++st) {
        ATT_SB();
        if (NOMAX) {
#pragma unroll
            for (int i = 0; i < 16; ++i) s0[i] = 0.f;
        } else s0 = negm;
#pragma unroll
        for (int ks = 0; ks < 4; ++ks) s0 = __builtin_amdgcn_mfma_f32_32x32x16_bf16(ka[ks], qf[ks], s0, 0, 0, 0);
        ATT_SB();
#pragma unroll
        for (int db = 0; db < 2; ++db)
#pragma unroll
            for (int s2 = 0; s2 < 2; ++s2) { const int kbyte = 2 * (32 * st + 16 * s2 + 4 * h); vl[db][s2] = *(const LAS u32x2*)(vb_ + (32 * db + r) * VT_STRIDE + kbyte); vh[db][s2] = *(const LAS u32x2*)(vb_ + (32 * db + r) * VT_STRIDE + kbyte + 16); }
        ATT_SB();
        attn_softmax<NOMAX>(s0, o0, o1, negm, m, lsum, pf, domask, klo0 + 32 * st, qpos0, qr, h);
        ATT_SB();
        if (st < 3) ATT_KLOAD(st + 1);
        ATT_SB();
#pragma unroll
        for (int s2 = 0; s2 < 2; ++s2) {
            const bf16x8 va0 = __builtin_bit_cast(bf16x8, (u32x4){vl[0][s2].x, vl[0][s2].y, vh[0][s2].x, vh[0][s2].y}), va1 = __builtin_bit_cast(bf16x8, (u32x4){vl[1][s2].x, vl[1][s2].y, vh[1][s2].x, vh[1][s2].y});
            o0 = __builtin_amdgcn_mfma_f32_32x32x16_bf16(va0, pf[s2], o0, 0, 0, 0); o1 = __builtin_amdgcn_mfma_f32_32x32x16_bf16(va1, pf[s2], o1, 0, 0, 0); }
    }
    ATT_SB();
#undef ATT_KLOAD
}
template <bool NOMAX>
DI void attn_run(const Frame& F, int u0, int u1, const float* sink) {
    const int tid = F.tid, lane = F.lane, w = F.wave, r = lane & 31, h = lane >> 5;
    LAS unsigned char* lds = F.lds;
    const int qr = 32 * (w & 3) + r;
    const int krow = tid >> 3, kch = tid & 7, vrow = tid >> 4, vch = tid & 15;
    u32x4 kreg0, kreg1, vreg0, vreg1;
#define ATT_LOAD(U, t2) do { const int _p = ((t2) < (U).nloc2) ? 128 * ((U).jt0h + (t2)) : SEQ + 128 * ((t2) - (U).nloc2); \
        kreg0 = *(const u32x4*)((U).K + (size_t)(_p + krow) * HD + 8 * kch); kreg1 = *(const u32x4*)((U).K + (size_t)(_p + 64 + krow) * HD + 8 * kch); \
        vreg0 = *(const u32x4*)((U).Vt + (size_t)vrow * KPOS + _p + 8 * vch); vreg1 = *(const u32x4*)((U).Vt + (size_t)(32 + vrow) * KPOS + _p + 8 * vch); } while (0)
#define ATT_STORE(buf) do { LAS unsigned char* _b = lds + (buf) * KV_BUF; \
        *(LAS u32x4*)(_b + krow * KT_STRIDE + 16 * kch) = kreg0; *(LAS u32x4*)(_b + (64 + krow) * KT_STRIDE + 16 * kch) = kreg1; \
        LAS u32x2* _v0 = (LAS u32x2*)(_b + KT_BYTES + vrow * VT_STRIDE + 16 * vch); _v0[0] = (u32x2){vreg0.x, vreg0.y}; _v0[1] = (u32x2){vreg0.z, vreg0.w}; \
        LAS u32x2* _v1 = (LAS u32x2*)(_b + KT_BYTES + (32 + vrow) * VT_STRIDE + 16 * vch); _v1[0] = (u32x2){vreg1.x, vreg1.y}; _v1[1] = (u32x2){vreg1.z, vreg1.w}; } while (0)
#define ATT_LOADQ(U) do { const bf16_t* _qp = (U).Q + ((U).qrow0 + qr) * 256 + (2 * (U).kvh + (w >> 2)) * 64 + 8 * h; \
        _Pragma("unroll") for (int ks = 0; ks < 4; ++ks) qn[ks] = *(const bf16x8*)(_qp + 16 * ks); } while (0)
    int u = u0 + F.bid;
    __syncthreads();
    if (u < u1) {
        AUnit cur = attn_desc(F, u);
        bf16x8 qn[4];
        ATT_LOADQ(cur); ATT_LOAD(cur, 0); ATT_STORE(0);
        __syncthreads();
        int buf = 0;
        for (;;) {
            const int un = u + F.G; const bool has_next = un < u1;
            bf16x8 qf[4];
#pragma unroll
            for (int ks = 0; ks < 4; ++ks) qf[ks] = qn[ks];
            const int hq = 2 * cur.kvh + (w >> 2);
            f32x16 o0, o1, negm;
            float m = (!NOMAX && cur.use_sink) ? sink[hq] * LOG2E : 0.0f;
#pragma unroll
            for (int i = 0; i < 16; ++i) { o0[i] = 0.f; o1[i] = 0.f; negm[i] = -m; }
            float lsum = (!NOMAX && cur.use_sink && h == 0) ? 1.0f : 0.0f;
            for (int t2 = 0; t2 < cur.nt2; ++t2) {
                const bool last = t2 + 1 == cur.nt2;
                if (!last) ATT_LOAD(cur, t2 + 1);
                else if (has_next) { const AUnit nxt = attn_desc(F, un); ATT_LOAD(nxt, 0); ATT_LOADQ(nxt); }
                if (w >= 4) __builtin_amdgcn_s_sleep(ATT_STAGGER);
                LAS unsigned char* kb_ = lds + buf * KV_BUF; LAS unsigned char* vb_ = kb_ + KT_BYTES;
                attn_tile<NOMAX>(kb_, vb_, qf, o0, o1, negm, m, lsum, cur.masked && t2 < cur.nloc2, 128 * (cur.jt0h + t2), cur.qpos0, qr, r, h);
                if (!last || has_next) ATT_STORE(buf ^ 1);
                __syncthreads();
                buf ^= 1;
            }
            const float ltot = xor32_sum(lsum);
            const float inv = 1.0f / ltot;
            bf16_t* yp = F.Y() + (cur.qrow0 + qr) * D + cur.ycol + hq * 64 + 4 * h;
#pragma unroll
            for (int g = 0; g < 4; ++g) { u32x2 v0, v1;
                v0.x = pk_bf16(o0[4 * g] * inv, o0[4 * g + 1] * inv); v0.y = pk_bf16(o0[4 * g + 2] * inv, o0[4 * g + 3] * inv);
                v1.x = pk_bf16(o1[4 * g] * inv, o1[4 * g + 1] * inv); v1.y = pk_bf16(o1[4 * g + 2] * inv, o1[4 * g + 3] * inv);
                *(u32x2*)(yp + 8 * g) = v0; *(u32x2*)(yp + 32 + 8 * g) = v1; }
            if (!has_next) break;
            cur = attn_desc(F, un); u = un;
        }
    }
#undef ATT_LOAD
#undef ATT_STORE
#undef ATT_LOADQ
    __syncthreads();
}
DI void phase_attn(const Frame& F0, int l) {
    const Frame F = refresh(F0);
    const int nunits = (l == NL - 1) ? 2048 : 2304;
    const float* sink = F.P->in[I_SINK] + l * 4;
    float gq = fabsf(F.P->in[I_QNG][l * 64 + F.lane]), gk = fabsf(F.P->in[I_KNG][l * 64 + F.lane]);
    gq = wave_max(gq); gk = wave_max(gk);
    const float sbound = 8.0f * gq * gk * LOG2E * 1.02f;
    if (sbound < 40.0f) { attn_run<true>(F, 0, 1024, sink); attn_run<false>(F, 1024, nunits, sink); }
    else attn_run<false>(F, 0, nunits, sink);
}

constexpr int PH_PER_LAYER = 9, N_PHASES = 1 + NL * PH_PER_LAYER + 1;

__global__ void __launch_bounds__(NTHREADS, 2) mk_fwd(const Params args) {
    extern __shared__ __attribute__((aligned(16))) unsigned char lds_raw[];
    Frame F;
    F.lds = (LAS unsigned char*)lds_raw;
    F.tid = threadIdx.x; F.lane = F.tid & 63; F.wave = __builtin_amdgcn_readfirstlane(F.tid >> 6); F.G = gridDim.x; F.bid = blockIdx.x;
    F.P = (const __attribute__((address_space(4))) Params*)__builtin_amdgcn_kernarg_segment_ptr();

    volatile LAS unsigned* MISC = (volatile LAS unsigned*)(F.lds + MISC_OFF);
    if (F.tid < 64) MISC[F.tid] = 0u;
    __syncthreads();
    XcdBarrier bar; bar.bar = (unsigned*)(F.P->ws + WS_CTL); bar.x = 0; bar.st = nullptr;
    if (!MK_PER_PHASE) bar = xcd_barrier_post((unsigned*)(F.P->ws + WS_CTL), MISC + 8);

    const int lo = F.P->ph_lo, hi = F.P->ph_hi;
#define IN(k) (lo <= (k) && (k) < hi)
#define SEAM(k) do { if (IN((k) + 1)) xcd_barrier(bar); } while (0)

    if (PH_ON(0) && IN(0)) { for (int r = 0; r < REP(0); ++r) phase_prologue(F); SEAM(0); }

    for (int l = 0; l < NL; ++l) {
        const int p0 = 1 + l * PH_PER_LAYER;
        const bool lastl = (l == NL - 1);
        if (PH_ON(1) && IN(p0 + 0)) { for (int r = 0; r < REP(1); ++r) convert_weights(F, l); if (l == 0) { for (int r = 0; r < REP(11); ++r) phase_norm1<true>(F, 0); } else phase_norm1<false>(F, l); SEAM(p0 + 0); }
        if (PH_ON(2) && IN(p0 + 1)) {
            pg8::RectOrder S; S.init(NTOK / 256, INW / 256, F.G, F.bid); S.A = (const char*)F.H(); S.B = (const char*)F.WIN(); S.tstride = (size_t)256 * D;
            pg8::EpiPI8 E{F.R1(), INW, F.hs(), F.wmax() + l * INW};
            for (int r = 0; r < REP(2); ++r) pg8::gemm_phase<false, 2>(F.lds, S, E);
            SEAM(p0 + 1);
        }
        if (PH_ON(3) && IN(p0 + 2)) { for (int r = 0; r < REP(3); ++r) phase_prep(F, l); SEAM(p0 + 2); }
        if (PH_ON(4) && IN(p0 + 3)) { for (int r = 0; r < REP(4); ++r) phase_attn(F, l); SEAM(p0 + 3); }
        if (PH_ON(5) && IN(p0 + 4)) {
            pg8::RectOrder S; S.init((lastl ? NLAT : NTOK) / 256, D / 256, F.G, F.bid); S.A = (const char*)F.Y(); S.B = (const char*)F.WOUT(); S.tstride = (size_t)256 * D * 2;
            pg8::EpiDelta E{F.R1(), F.mods() + (size_t)l * 33 * 6144};
            for (int r = 0; r < REP(5); ++r) pg8::gemm_phase(F.lds, S, E);
            SEAM(p0 + 4);
        }
        if (PH_ON(6) && IN(p0 + 5)) { if (l == 0) phase_norm2_router<true>(F, l); else phase_norm2_router<false>(F, l); SEAM(p0 + 5); }
        if (PH_ON(7) && IN(p0 + 6)) { for (int r = 0; r < REP(7); ++r) phase_topk(F, l); SEAM(p0 + 6); }
        if (PH_ON(8) && IN(p0 + 7)) {
            pg8::MoeOrder S; S.init(lastl ? 512 : 576, 8, F.G, F.bid); S.A = (const char*)F.H(); S.B = (const char*)F.WGU(); S.estride = (size_t)2 * D * D; S.tstride = (size_t)256 * D; S.ridx = F.idx();
            pg8::EpiGU E{(unsigned char*)F.Gb()};
            for (int r = 0; r < REP(8); ++r) pg8::gemm_phase<true, 1>(F.lds, S, E);
            SEAM(p0 + 7);
        }
        if (PH_ON(9) && IN(p0 + 8)) {
            pg8::MoeOrder S; S.init(lastl ? 512 : 576, 4, F.G, F.bid); S.A = (const char*)F.Gb(); S.B = (const char*)F.WD(); S.estride = (size_t)D * D; S.tstride = (size_t)256 * D; S.ridx = nullptr;
            pg8::EpiDown E{(unsigned char*)F.R1(), F.gate()};
            for (int r = 0; r < REP(9); ++r) pg8::gemm_phase<false, 1>(F.lds, S, E);
            SEAM(p0 + 8);
        }
    }
    if (PH_ON(10) && IN(N_PHASES - 1)) phase_norm1<false>(F, NL);
#undef IN
#undef SEAM
}

extern "C" void kernel_launch(void* const* d_in, const int* in_sizes, int n_in, void* d_out, int out_size, void* d_ws, size_t ws_size, hipStream_t stream) {
    static int grid = 0;
    if (grid == 0) {
        if (n_in != 23 || out_size != NLAT * D || ws_size < WS_END) { fprintf(stderr, "kernel_launch: unexpected problem (n_in %d, out %d, ws %zu < %zu)\n", n_in, out_size, ws_size, (size_t)WS_END); grid = -1; return; }
        int dev = 0, cus = 0;
        if (hipGetDevice(&dev) != hipSuccess || hipDeviceGetAttribute(&cus, hipDeviceAttributeMultiprocessorCount, dev) != hipSuccess) { grid = -1; return; }
        if (hipFuncSetAttribute((const void*)mk_fwd, hipFuncAttributeMaxDynamicSharedMemorySize, LDS_BYTES) != hipSuccess) { fprintf(stderr, "kernel_launch: hipFuncSetAttribute failed\n"); grid = -1; return; }
        int per_cu = 0;
        if (hipOccupancyMaxActiveBlocksPerMultiprocessor(&per_cu, (const void*)mk_fwd, NTHREADS, LDS_BYTES) != hipSuccess || per_cu < 1) { fprintf(stderr, "kernel_launch: occupancy query says %d blocks per CU\n", per_cu); }
        (void)hipGetLastError();
        grid = cus;
    }
    if (grid < 0) return;
    (void)hipMemsetAsync((char*)d_ws + WS_CTL, 0, 65536, stream);
    Params p{};
    for (int i = 0; i < 23; ++i) p.in[i] = (const float*)d_in[i];
    p.out = (float*)d_out; p.ws = (unsigned char*)d_ws;
#if MK_PER_PHASE
    for (int ph = 0; ph < N_PHASES; ++ph) { p.ph_lo = ph; p.ph_hi = ph + 1; hipLaunchKernelGGL(mk_fwd, dim3(grid), dim3(NTHREADS), LDS_BYTES, stream, p); }
#else
    p.ph_lo = 0; p.ph_hi = N_PHASES;
    hipLaunchKernelGGL(mk_fwd, dim3(grid), dim3(NTHREADS), LDS_BYTES, stream, p);
#endif
}
```
